# Optimizing an MI355X kernel written in HIP

```python
import math
import jax, jax.numpy as jnp
from jax import lax
import numpy as np

D_MODEL = 4096
BATCH = 2
SEQ = 8192
DEPTH = 1
DEC_BATCH = 16
DEC_SEQ = 64
PAST_LEN = 2048

CHUNK = 64
EPS = 1e-6

M_EXPAND = 2
M_D_INNER = M_EXPAND * D_MODEL
M_HEAD_DIM = 64
M_HEADS = M_D_INNER // M_HEAD_DIM
M_GROUPS = 8
M_HPG = M_HEADS // M_GROUPS
M_STATE = 128
M_CONV = 4
M_BC = M_GROUPS * M_STATE
M_CONV_DIM = M_D_INNER + 2 * M_BC

A_HEAD_DIM = 64
A_HEADS = D_MODEL // (2 * A_HEAD_DIM)
A_KV_HEADS = 8
A_REP = A_HEADS // A_KV_HEADS
A_WIDTH = A_HEADS * 2 * A_HEAD_DIM
A_KV_WIDTH = A_KV_HEADS * 2 * A_HEAD_DIM
ROPE_DIM = A_HEAD_DIM // 4
ROPE_THETA = 500000.0
Q_BLOCK = 128

IN_SIZES = (M_D_INNER, M_CONV_DIM, M_HEADS, A_WIDTH, A_KV_WIDTH, A_KV_WIDTH, A_WIDTH, D_MODEL, D_MODEL)
IN_TOTAL = sum(IN_SIZES)

kernel_name = 'hybrid_ssd_diffattn_stream_step'


def lambda_init(layer_idx):
    return 0.8 - 0.6 * math.exp(-0.3 * layer_idx)


def rms_norm(x, w):
    xf = x.astype(jnp.float32)
    y = xf * lax.rsqrt(jnp.mean(xf * xf, axis=-1, keepdims=True) + EPS)
    return (y * w.astype(jnp.float32)).astype(x.dtype)


def partial_rope(t, pos):
    half = ROPE_DIM // 2
    inv = ROPE_THETA ** (-jnp.arange(half, dtype=jnp.float32) / half)
    ang = pos.astype(jnp.float32)[:, None] * inv[None, :]
    shape = (1, t.shape[1]) + (1,) * (t.ndim - 3) + (half,)
    cos = jnp.cos(ang).reshape(shape)
    sin = jnp.sin(ang).reshape(shape)
    r1 = t[..., :half].astype(jnp.float32)
    r2 = t[..., half:ROPE_DIM].astype(jnp.float32)
    rot = jnp.concatenate([r1 * cos - r2 * sin, r2 * cos + r1 * sin], axis=-1).astype(t.dtype)
    return jnp.concatenate([rot, t[..., ROPE_DIM:]], axis=-1)


def ssd_chunk(x, dt, bm, cm, a, state):
    L = x.shape[1]
    acum = jnp.cumsum(dt * a, axis=1)
    seg = acum[:, :, None] - acum[:, None, :]
    causal = jnp.tril(jnp.ones((L, L), dtype=bool))[None, :, :, None, None]
    decay = jnp.exp(jnp.where(causal, seg, -jnp.inf))
    xdt = x.astype(jnp.float32) * dt[..., None]
    bf = bm.astype(jnp.float32)
    cf = cm.astype(jnp.float32)
    sf = state.astype(jnp.float32)
    cb = jnp.einsum('blgn,bsgn->blsg', cf, bf)
    y_diag = jnp.einsum('blsg,blsgj,bsgjp->blgjp', cb, decay, xdt)
    y_off = jnp.einsum('blgn,bgjpn->blgjp', cf, sf) * jnp.exp(acum)[..., None]
    to_end = jnp.exp(acum[:, -1:] - acum)
    new_state = sf * jnp.exp(acum[:, -1])[..., None, None] + jnp.einsum('bsgn,bsgj,bsgjp->bgjpn', bf, to_end, xdt)
    return (y_diag + y_off).astype(x.dtype), new_state.astype(state.dtype)


def mamba_branch(z, xbc, dt_raw, conv_state, ssm_state, conv_w, conv_b, dt_bias, a_log, d_skip, norm_w):
    b, T, _ = xbc.shape
    xp = jnp.concatenate([conv_state, xbc], axis=1)
    new_conv = xp[:, -(M_CONV - 1):]
    conv = conv_b + sum(xp[:, k:k + T] * conv_w[k] for k in range(M_CONV))
    conv = jax.nn.silu(conv)
    xs, bm, cm = jnp.split(conv, [M_D_INNER, M_D_INNER + M_BC], axis=-1)
    xs = xs.reshape(b, T, M_GROUPS, M_HPG, M_HEAD_DIM)
    bm = bm.reshape(b, T, M_GROUPS, M_STATE)
    cm = cm.reshape(b, T, M_GROUPS, M_STATE)
    dt = jax.nn.softplus(dt_raw.astype(jnp.float32) + dt_bias.astype(jnp.float32)).reshape(b, T, M_GROUPS, M_HPG)
    a = -jnp.exp(a_log.astype(jnp.float32)).reshape(M_GROUPS, M_HPG)
    L = min(CHUNK, T)
    nc = T // L

    def to_chunks(t):
        return jnp.moveaxis(t.reshape((b, nc, L) + t.shape[2:]), 1, 0)

    def step(state, inp):
        xc, dtc, bc, cc = inp
        y, state = ssd_chunk(xc, dtc, bc, cc, a, state)
        return state, y

    s0 = ssm_state.reshape(b, M_GROUPS, M_HPG, M_HEAD_DIM, M_STATE)
    s_final, ys = lax.scan(step, s0, (to_chunks(xs), to_chunks(dt), to_chunks(bm), to_chunks(cm)))
    y = jnp.moveaxis(ys, 0, 1).reshape(b, T, M_GROUPS, M_HPG, M_HEAD_DIM)
    y = y + (d_skip.reshape(M_GROUPS, M_HPG)[..., None] * xs).astype(y.dtype)
    y = y.reshape(b, T, M_D_INNER) * jax.nn.silu(z)
    y = rms_norm(y.reshape(b, T, M_GROUPS, M_D_INNER // M_GROUPS), norm_w.reshape(M_GROUPS, -1))
    return y.reshape(b, T, M_D_INNER), new_conv, s_final.reshape(b, M_HEADS, M_HEAD_DIM, M_STATE)


def diff_attn_branch(q, k, v, za, k_past, v_past, q_pos, k_pos, lq1, lk1, lq2, lk2, norm_w, lam_init):
    b, T, _ = q.shape
    q = partial_rope(q.reshape(b, T, A_KV_HEADS, A_REP, 2, A_HEAD_DIM), q_pos)
    k = partial_rope(k.reshape(b, T, A_KV_HEADS, 2, A_HEAD_DIM), q_pos)
    v = v.reshape(b, T, A_KV_HEADS, 2 * A_HEAD_DIM)
    k_all = jnp.concatenate([k_past, k], axis=1)
    v_all = jnp.concatenate([v_past, v], axis=1)
    lam = (jnp.exp(jnp.sum(lq1.astype(jnp.float32) * lk1.astype(jnp.float32)))
           - jnp.exp(jnp.sum(lq2.astype(jnp.float32) * lk2.astype(jnp.float32))) + lam_init)
    qb = min(Q_BLOCK, T)
    nb = T // qb
    q_blocks = jnp.moveaxis(q.reshape((b, nb, qb) + q.shape[2:]), 1, 0)
    pos_blocks = q_pos.reshape(nb, qb)
    k_chunk = k_pos // CHUNK

    def attend(args):
        qi, pi = args
        mask = k_chunk[None, :] <= (pi // CHUNK)[:, None]
        s = jnp.einsum('bqhrcd,bshcd->bhrcqs', qi, k_all, preferred_element_type=jnp.float32) * (A_HEAD_DIM ** -0.5)
        s = jnp.where(mask[None, None, None, None], s, -jnp.inf)
        p = jax.nn.softmax(s, axis=-1)
        w = p[:, :, :, 0] - lam * p[:, :, :, 1]
        return jnp.einsum('bhrqs,bshe->bqhre', w.astype(v_all.dtype), v_all)

    o = lax.map(attend, (q_blocks, pos_blocks))
    o = jnp.moveaxis(o, 0, 1).reshape(b, T, A_KV_HEADS, A_REP, 2 * A_HEAD_DIM)
    o = rms_norm(o, norm_w) * (1.0 - lam_init)
    o = o.reshape(b, T, A_WIDTH) * jax.nn.silu(za)
    return o, k, v


def mixer_layer(x, c, q_pos, k_pos, k_past, v_past, conv_state, ssm_state, p, lam_init):
    mod = jax.nn.silu(c) @ p['w_ada'] + p['b_ada']
    shift, scale, gate = jnp.split(mod, 3, axis=-1)
    h = rms_norm(x, p['norm_w']) * (1.0 + scale[:, None, :]) + shift[:, None, :]
    proj = h @ p['w_in']
    splits = np.cumsum(IN_SIZES)[:-1].tolist()
    z_m, xbc, dt, q, k, v, z_a, g_m, g_a = jnp.split(proj, splits, axis=-1)
    y_m, new_conv, new_ssm = mamba_branch(z_m, xbc, dt, conv_state, ssm_state, p['conv_w'], p['conv_b'],
                                          p['dt_bias'], p['a_log'], p['d_skip'], p['mamba_norm_w'])
    y_a, k_new, v_new = diff_attn_branch(q, k, v, z_a, k_past, v_past, q_pos, k_pos, p['lam_q1'], p['lam_k1'],
                                         p['lam_q2'], p['lam_k2'], p['attn_norm_w'], lam_init)
    merged = jax.nn.sigmoid(g_m) * (y_m @ p['w_proj_m']) + jax.nn.sigmoid(g_a) * (y_a @ p['w_proj_a'])
    x = x + gate[:, None, :] * (merged @ p['w_out'])
    return x, k_new, v_new, new_conv, new_ssm


def setup_inputs(seed: int = 0) -> dict:
    key = jax.random.key(seed)
    ks = jax.random.split(key, 32)

    def nrm(k, shape, s):
        return jax.random.normal(k, shape, jnp.float32) * s

    u = jax.random.uniform(ks[12], (DEPTH, M_HEADS), jnp.float32)
    dt0 = jnp.exp(u * (math.log(0.1) - math.log(0.001)) + math.log(0.001))
    return {
        'x_prompt': nrm(ks[0], (BATCH, SEQ, D_MODEL), 1.0),
        'x_sample': nrm(ks[1], (DEC_BATCH, DEC_SEQ, D_MODEL), 1.0),
        'cache_k': nrm(ks[2], (DEPTH, DEC_BATCH, PAST_LEN, A_KV_HEADS, 2, A_HEAD_DIM), 1.0),
        'cache_v': nrm(ks[3], (DEPTH, DEC_BATCH, PAST_LEN, A_KV_HEADS, 2 * A_HEAD_DIM), 1.0),
        'state_conv': nrm(ks[4], (DEPTH, DEC_BATCH, M_CONV - 1, M_CONV_DIM), 1.0),
        'state_ssm': nrm(ks[5], (DEPTH, DEC_BATCH, M_HEADS, M_HEAD_DIM, M_STATE), 0.5),
        'c_prompt': nrm(ks[6], (BATCH, D_MODEL), 1.0),
        'c_sample': nrm(ks[7], (DEC_BATCH, D_MODEL), 1.0),
        'w_ada': nrm(ks[8], (DEPTH, D_MODEL, 3 * D_MODEL), 0.5 * D_MODEL ** -0.5),
        'b_ada': nrm(ks[9], (DEPTH, 3 * D_MODEL), 0.01),
        'norm_w': 1.0 + nrm(ks[10], (DEPTH, D_MODEL), 0.02),
        'w_in': nrm(ks[11], (DEPTH, D_MODEL, IN_TOTAL), D_MODEL ** -0.5),
        'conv_w': nrm(ks[13], (DEPTH, M_CONV, M_CONV_DIM), M_CONV ** -0.5),
        'conv_b': nrm(ks[14], (DEPTH, M_CONV_DIM), 0.01),
        'dt_bias': dt0 + jnp.log(-jnp.expm1(-dt0)),
        'a_log': jnp.log(jax.random.uniform(ks[15], (DEPTH, M_HEADS), jnp.float32, 1.0, 16.0)),
        'd_skip': 1.0 + nrm(ks[16], (DEPTH, M_HEADS), 0.1),
        'mamba_norm_w': 1.0 + nrm(ks[17], (DEPTH, M_D_INNER), 0.02),
        'lam_q1': nrm(ks[18], (DEPTH, A_HEAD_DIM), 0.1),
        'lam_k1': nrm(ks[19], (DEPTH, A_HEAD_DIM), 0.1),
        'lam_q2': nrm(ks[20], (DEPTH, A_HEAD_DIM), 0.1),
        'lam_k2': nrm(ks[21], (DEPTH, A_HEAD_DIM), 0.1),
        'attn_norm_w': 1.0 + nrm(ks[22], (DEPTH, 2 * A_HEAD_DIM), 0.02),
        'w_proj_m': nrm(ks[23], (DEPTH, M_D_INNER, D_MODEL), M_D_INNER ** -0.5),
        'w_proj_a': nrm(ks[24], (DEPTH, A_WIDTH, D_MODEL), A_WIDTH ** -0.5),
        'w_out': nrm(ks[25], (DEPTH, D_MODEL, D_MODEL), D_MODEL ** -0.5),
        'final_norm_w': 1.0 + nrm(ks[26], (D_MODEL,), 0.02),
    }


def reference(x_prompt, x_sample, cache_k, cache_v, state_conv, state_ssm, c_prompt, c_sample,
              w_ada, b_ada, norm_w, w_in, conv_w, conv_b, dt_bias, a_log, d_skip, mamba_norm_w,
              lam_q1, lam_k1, lam_q2, lam_k2, attn_norm_w, w_proj_m, w_proj_a, w_out, final_norm_w):
    b, T = x_prompt.shape[0], x_prompt.shape[1]
    ts = x_sample.shape[1]
    past = cache_k.shape[2]
    pos_p = jnp.arange(T, dtype=jnp.int32)
    pos_s = past + jnp.arange(ts, dtype=jnp.int32)
    kpos_s = jnp.arange(past + ts, dtype=jnp.int32)
    dt_ = x_prompt.dtype
    empty_k = jnp.zeros((b, 0, A_KV_HEADS, 2, A_HEAD_DIM), dt_)
    empty_v = jnp.zeros((b, 0, A_KV_HEADS, 2 * A_HEAD_DIM), dt_)
    zero_conv = jnp.zeros((b, M_CONV - 1, M_CONV_DIM), dt_)
    zero_ssm = jnp.zeros((b, M_HEADS, M_HEAD_DIM, M_STATE), dt_)
    hp, hs = x_prompt, x_sample
    k_p, v_p, conv_p, ssm_p = [], [], [], []
    k_s, v_s, conv_s, ssm_s = [], [], [], []
    for i in range(DEPTH):
        p = {'w_ada': w_ada[i], 'b_ada': b_ada[i], 'norm_w': norm_w[i], 'w_in': w_in[i],
             'conv_w': conv_w[i], 'conv_b': conv_b[i], 'dt_bias': dt_bias[i], 'a_log': a_log[i],
             'd_skip': d_skip[i], 'mamba_norm_w': mamba_norm_w[i], 'lam_q1': lam_q1[i], 'lam_k1': lam_k1[i],
             'lam_q2': lam_q2[i], 'lam_k2': lam_k2[i], 'attn_norm_w': attn_norm_w[i],
             'w_proj_m': w_proj_m[i], 'w_proj_a': w_proj_a[i], 'w_out': w_out[i]}
        li = lambda_init(i)
        hp, kp, vp, cp, sp = mixer_layer(hp, c_prompt, pos_p, pos_p, empty_k, empty_v, zero_conv, zero_ssm, p, li)
        hs, kq, vq, cq, sq = mixer_layer(hs, c_sample, pos_s, kpos_s, cache_k[i], cache_v[i],
                                         state_conv[i], state_ssm[i], p, li)
        k_p.append(kp); v_p.append(vp); conv_p.append(cp); ssm_p.append(sp)
        k_s.append(kq); v_s.append(vq); conv_s.append(cq); ssm_s.append(sq)
    y_prompt = rms_norm(hp, final_norm_w)
    y_sample = rms_norm(hs, final_norm_w)
    return (y_prompt, y_sample, jnp.stack(k_p), jnp.stack(v_p), jnp.stack(conv_p), jnp.stack(ssm_p),
            jnp.stack(k_s), jnp.stack(v_s), jnp.stack(conv_s), jnp.stack(ssm_s))
```

```cpp
#include <hip/hip_runtime.h>
#include <cstdio>
#include <cstdint>

#define GAS __attribute__((address_space(1)))
#define LAS __attribute__((address_space(3)))
typedef unsigned short bf16;
typedef short bf16x8 __attribute__((ext_vector_type(8)));
typedef float f32x4 __attribute__((ext_vector_type(4)));
typedef float f32x2 __attribute__((ext_vector_type(2)));
typedef float f32x16 __attribute__((ext_vector_type(16)));
typedef unsigned u32x4 __attribute__((ext_vector_type(4)));
typedef unsigned u32x2 __attribute__((ext_vector_type(2)));

#ifndef MK_N_LAUNCHES
#define MK_N_LAUNCHES 1
#endif
constexpr int N_PHASES = 10;
#ifndef USE_SPLIT
#define USE_SPLIT 1
#endif
#ifndef REP_P0
#define REP_P0 1
#endif
#ifndef REP_P2
#define REP_P2 1
#endif
#ifndef REP_P3
#define REP_P3 1
#endif
#ifndef REP_SSD
#define REP_SSD 1
#endif
#ifndef REP_ATT
#define REP_ATT 1
#endif
#ifndef REP_P6
#define REP_P6 1
#endif
#ifndef REP_P7
#define REP_P7 1
#endif

constexpr int D = 4096, MP = 16384, MS = 1024, M = MP + MS;
constexpr int NIN = 37120;
constexpr int DI = 8192, CD = 10240, NH = 128;
constexpr float EPS = 1e-6f;
constexpr float QSCALE = 0.125f * 1.4426950408889634f;

constexpr size_t O_Y = 0, O_KP = 71303168, O_VP = 88080384, O_CP = 104857600, O_SP = 104919040, O_KS = 107016192, O_VS = 108064768, O_CS = 109113344, O_SS = 109604864;

constexpr size_t MiB = 1u << 20;
constexpr size_t WS_CTL = 0, CTL_ZERO_BYTES = 2 * MiB;
constexpr size_t WS_MOD = 1 * MiB;
constexpr size_t WS_ROPE = 2 * MiB;
constexpr size_t WS_WPM = 4 * MiB, WS_WPA = 68 * MiB, WS_WOUT = 100 * MiB, WS_WIN = 132 * MiB;
constexpr size_t WS_YM = WS_WIN;
constexpr size_t WS_H = 422 * MiB;
constexpr size_t WS_YA = WS_H;
constexpr size_t WS_ZM = 558 * MiB;
constexpr size_t WS_MERGED = WS_ZM;
constexpr size_t WS_XBC = 830 * MiB;
constexpr size_t WS_PARK = WS_XBC;
constexpr size_t WS_T1 = WS_XBC;
constexpr size_t WS_Q = 1170 * MiB, WS_KB = 1306 * MiB, WS_VB = 1338 * MiB, WS_KS = 1370 * MiB, WS_VS = 1436 * MiB;
constexpr size_t WS_ZA = 1502 * MiB, WS_GM = 1638 * MiB, WS_GA = 1774 * MiB, WS_DT = 1910 * MiB;
constexpr size_t WS_XT = 1920 * MiB, WS_BN = 2192 * MiB, WS_BT = 2226 * MiB, WS_CN = 2260 * MiB, WS_END = 2294 * MiB;
constexpr size_t WS_TS = WS_Q;
constexpr size_t WS_DLT = WS_ZA;
constexpr size_t WS_PS = WS_KB;
constexpr int CW_BAR = 4096;

constexpr int RING_BYTES = 131072, LDS_BYTES = 147456, LDSCTL_OFF = LDS_BYTES - 512, MISC_OFF = LDSCTL_OFF + 320;

__device__ __forceinline__ unsigned cvt_pk_bf16(float lo, float hi) { unsigned r; asm volatile("v_cvt_pk_bf16_f32 %0, %1, %2" : "=v"(r) : "v"(lo), "v"(hi)); return r; }
__device__ __forceinline__ float bf_lo(unsigned u) { return __uint_as_float(u << 16); }
__device__ __forceinline__ float bf_hi(unsigned u) { return __uint_as_float(u & 0xffff0000u); }
__device__ __forceinline__ float bf2f(bf16 b) { return __uint_as_float((unsigned)b << 16); }
__device__ __forceinline__ bf16 f2bf(float f) { return (bf16)(cvt_pk_bf16(f, 0.f) & 0xffffu); }
__device__ __forceinline__ float silu_f(float x) { return x * __builtin_amdgcn_rcpf(1.f + __expf(-x)); }
__device__ __forceinline__ float sigm_f(float x) { return __builtin_amdgcn_rcpf(1.f + __expf(-x)); }
__device__ __forceinline__ float wave_sum(float v) {
#pragma unroll
    for (int o = 1; o < 64; o <<= 1) v += __shfl_xor(v, o);
    return v;
}
#define LBAR() do { asm volatile("s_waitcnt lgkmcnt(0)" ::: "memory"); __builtin_amdgcn_s_barrier(); asm volatile("" ::: "memory"); } while (0)

namespace pg8 {
#define PG8_LAS __attribute__((address_space(3)))
typedef unsigned short bf16_t;
constexpr int BM = 256, BK = 64, HALF = 128, HTB = HALF * BK * 2, STAGE_BYTES = 8 * HTB, NXCD = 8, WGM = 8;
__host__ __device__ __forceinline__ int lds_byte(int r, int c) { const int st = (r >> 4) * 2 + (c >> 5), rr = r & 15, cc = c & 31, ob = rr * 64 + cc * 2; return st * 1024 + (ob ^ (((ob >> 9) & 1) << 5)); }
__host__ __device__ __forceinline__ void stage_rc(int b, int& R, int& C) { const int st = b / 1024, sb = b % 1024, swz = sb ^ (((sb >> 9) & 1) << 5); R = (st >> 1) * 16 + swz / 64; C = (st & 1) * 32 + (swz % 64) / 2; }
__host__ __device__ __forceinline__ int perm32(int rho) { const int n = rho >> 4, i = rho & 15; return 8 * (i >> 2) + 4 * n + (i & 3); }
struct Unit { int pm, pn, kq, nq; };
struct Gemm { const bf16_t* A; const bf16_t* Bt; int M, N, K; };
struct StaticOrder {
    int nM, nN, nwg, G, c;
    __host__ __device__ void init(int M_, int N_, int G_, int c_) { nM = M_ / BM; nN = N_ / BM; nwg = nM * nN; G = G_; c = c_; }
    __host__ __device__ bool next(int i, Unit& u) const {
        const long L = (long)i * G + c; if (L >= nwg) return false;
        int wgid = (int)L; { const int q = nwg / NXCD, r = nwg % NXCD, xcd = wgid % NXCD, off = wgid / NXCD; wgid = (xcd < r ? xcd * (q + 1) : r * (q + 1) + (xcd - r) * q) + off; }
        const int nig = WGM * nN, gid = wgid / nig, fm = gid * WGM, gsz = (nM - fm) < WGM ? (nM - fm) : WGM;
        u.pm = fm + ((wgid % nig) % gsz); u.pn = (wgid % nig) / gsz; u.kq = 0; u.nq = 1; return true;
    }
    __device__ __forceinline__ void a_ready(const Unit&) const {}
    __device__ __forceinline__ void done(const Unit&) const {}
};
struct SplitOrder {
    StaticOrder sp, sf; bool split; int c;
    __host__ __device__ void init(int G_, int c_) { split = USE_SPLIT && (G_ == 256); c = c_; sp.init(16384, 4096, G_, c_); sf.init(17408, 4096, G_, c_); }
    __host__ __device__ bool next(int i, Unit& u) const {
        if (!split) return sf.next(i, u);
        if (i == 0) { const int su = c >> 2; u.pm = 64 + (su >> 4); u.pn = su & 15; u.kq = c & 3; u.nq = 4; return true; }
        return sp.next(i - 1, u);
    }
    __device__ __forceinline__ void a_ready(const Unit&) const {}
    __device__ __forceinline__ void done(const Unit&) const {}
};
template <class Epi, class Sched, bool ALIGN_EPI = false, bool SP2 = false>
__device__ __forceinline__ void gemm_phase(PG8_LAS unsigned char* lds, const Gemm g, const Sched& S, const Epi& E) {
    const int tid = threadIdx.x, wid = __builtin_amdgcn_readfirstlane(tid >> 6), lane = tid & 63, wr = wid >> 2, wc = wid & 3, fr = lane & 15, fq = lane >> 4;
    const int K = g.K, nt = K / BK;
    unsigned voffA[2], voffB[2];
#pragma unroll
    for (int i = 0; i < 2; ++i) { int R, C; stage_rc(tid * 16 + i * 8192, R, C); const int Rb = Epi::PERM ? ((R & ~31) + perm32(R & 31)) : R;
        voffA[i] = (unsigned)(R * K + C) * 2u; voffB[i] = (unsigned)(Rb * K + C) * 2u; }
    const size_t kstep = (size_t)(BK * 2);
    const size_t hstep = (size_t)HALF * K * 2;
    const size_t tstep = 2 * hstep;
    const unsigned ldsw = (unsigned)wid * 1024u;
    const int aoff = lds_byte(wr * 64 + fr, fq * 8), boff = lds_byte(wc * 32 + fr, fq * 8);
#define PG8_SA(b, h) (((b) * 2 + (h)) * HTB)
#define PG8_SB(b, h) ((4 + (b) * 2 + (h)) * HTB)
#define PG8_STAGE(bufoff, gbase, voff) do { _Pragma("unroll") for (int _i = 0; _i < 2; ++_i) \
        __builtin_amdgcn_global_load_lds((const unsigned*)((const char*)(gbase) + (voff)[_i]), (PG8_LAS unsigned*)(lds + (bufoff) + ldsw + _i * 8192), 16, 0, 0); } while (0)
#define PG8_LDA(dst, b, h) do { _Pragma("unroll") for (int m = 0; m < 4; ++m) _Pragma("unroll") for (int k = 0; k < 2; ++k) dst[m][k] = *(const PG8_LAS bf16x8*)(lds + PG8_SA(b, h) + aoff + m * 2048 + k * 1024); } while (0)
#define PG8_LDB(dst, b, h) do { _Pragma("unroll") for (int n = 0; n < 2; ++n) _Pragma("unroll") for (int k = 0; k < 2; ++k) dst[n][k] = *(const PG8_LAS bf16x8*)(lds + PG8_SB(b, h) + boff + n * 2048 + k * 1024); } while (0)
#define PG8_MMA(ai, bj, At, Bt) do { __builtin_amdgcn_s_setprio(1); _Pragma("unroll") for (int m = 0; m < 4; ++m) _Pragma("unroll") for (int n = 0; n < 2; ++n) _Pragma("unroll") for (int k = 0; k < 2; ++k) \
        acc[ai][bj][m][n] = __builtin_amdgcn_mfma_f32_16x16x32_bf16(Bt[n][k], At[m][k], acc[ai][bj][m][n], 0, 0, 0); __builtin_amdgcn_s_setprio(0); } while (0)
#define PG8_WAIT_V(n) asm volatile("s_waitcnt vmcnt(" #n ")" ::: "memory")
#define PG8_WAIT_L(n) asm volatile("s_waitcnt lgkmcnt(" #n ")" ::: "memory")
#define PG8_BAR __builtin_amdgcn_s_barrier()
#define PG8_SCHED __builtin_amdgcn_sched_barrier(0)
    Unit cur, nxt; int ui = 0;
    if (!S.next(0, cur)) return;
    f32x4 acc[2][2][4][2];
#pragma unroll
    for (int a = 0; a < 2; ++a)
#pragma unroll
        for (int b = 0; b < 2; ++b)
#pragma unroll
            for (int m = 0; m < 4; ++m)
#pragma unroll
                for (int n = 0; n < 2; ++n) acc[a][b][m][n] = (f32x4){0.f, 0.f, 0.f, 0.f};
    bf16x8 At[4][2], B0[2][2], B1[2][2];
    int ntc = nt / cur.nq;
    const char* cA = (const char*)g.A + (size_t)cur.pm * tstep + (size_t)(cur.kq * ntc) * kstep; const char* cB = (const char*)g.Bt + (size_t)cur.pn * tstep + (size_t)(cur.kq * ntc) * kstep;
    S.a_ready(cur);
    if constexpr (SP2) {
        PG8_STAGE(PG8_SB(0, 0), cB, voffB); PG8_STAGE(PG8_SB(0, 1), cB + hstep, voffB); PG8_STAGE(PG8_SA(0, 0), cA, voffA); PG8_STAGE(PG8_SA(0, 1), cA + hstep, voffA);
        if (wr == 1) PG8_BAR;
        PG8_WAIT_V(2); PG8_BAR;
        PG8_STAGE(PG8_SB(1, 0), cB + kstep, voffB); PG8_STAGE(PG8_SA(1, 0), cA + kstep, voffA); PG8_STAGE(PG8_SB(1, 1), cB + hstep + kstep, voffB);
        PG8_WAIT_V(6); PG8_BAR;
    } else {
        PG8_STAGE(PG8_SB(0, 0), cB, voffB); PG8_STAGE(PG8_SA(0, 0), cA, voffA); PG8_STAGE(PG8_SB(0, 1), cB + hstep, voffB); PG8_STAGE(PG8_SA(0, 1), cA + hstep, voffA);
        if (wr == 1) PG8_BAR;
        PG8_WAIT_V(4); PG8_BAR;
        PG8_STAGE(PG8_SB(1, 0), cB + kstep, voffB); PG8_STAGE(PG8_SA(1, 0), cA + kstep, voffA); PG8_STAGE(PG8_SB(1, 1), cB + hstep + kstep, voffB);
        PG8_WAIT_V(6); PG8_BAR;
    }
    for (;;) {
        const bool has_next = S.next(ui + 1, nxt);
        const int ntn = has_next ? nt / nxt.nq : ntc;
        const char* nA = has_next ? (const char*)g.A + (size_t)nxt.pm * tstep + (size_t)(nxt.kq * ntn) * kstep : cA; const char* nB = has_next ? (const char*)g.Bt + (size_t)nxt.pn * tstep + (size_t)(nxt.kq * ntn) * kstep : cB;
        for (int t = 0; t < ntc; t += 2) {
            const bool last = (t == ntc - 2);
            const char* a1 = cA + (size_t)(t + 1) * kstep;
            const char* a2 = last ? nA : cA + (size_t)(t + 2) * kstep; const char* b2 = last ? nB : cB + (size_t)(t + 2) * kstep;
            const char* a3 = a2 + kstep; const char* b3 = b2 + kstep;
            if (last && has_next) S.a_ready(nxt);
            if constexpr (SP2) {
            PG8_LDB(B0, 0, 0); PG8_LDB(B1, 0, 1); PG8_SCHED; PG8_LDA(At, 0, 0); PG8_STAGE(PG8_SA(1, 1), a1 + hstep, voffA);
            PG8_WAIT_V(8); PG8_WAIT_L(0); PG8_BAR; PG8_MMA(0, 0, At, B0); PG8_MMA(0, 1, At, B1); PG8_BAR; PG8_SCHED;
            PG8_LDA(At, 0, 1); PG8_STAGE(PG8_SB(0, 0), b2, voffB); PG8_STAGE(PG8_SB(0, 1), b2 + hstep, voffB); PG8_STAGE(PG8_SA(0, 0), a2, voffA);
            PG8_WAIT_V(8); PG8_WAIT_L(0); PG8_BAR; PG8_MMA(1, 0, At, B0); PG8_MMA(1, 1, At, B1); PG8_BAR; PG8_SCHED;
            PG8_LDB(B0, 1, 0); PG8_LDB(B1, 1, 1); PG8_SCHED; PG8_LDA(At, 1, 0); PG8_STAGE(PG8_SA(0, 1), a2 + hstep, voffA);
            PG8_WAIT_V(8); PG8_WAIT_L(0); PG8_BAR; PG8_MMA(0, 0, At, B0); PG8_MMA(0, 1, At, B1); PG8_BAR; PG8_SCHED;
            PG8_LDA(At, 1, 1); PG8_STAGE(PG8_SB(1, 0), b3, voffB); PG8_STAGE(PG8_SB(1, 1), b3 + hstep, voffB); PG8_STAGE(PG8_SA(1, 0), a3, voffA);
            PG8_WAIT_V(8); PG8_WAIT_L(0); PG8_BAR; PG8_MMA(1, 0, At, B0); PG8_MMA(1, 1, At, B1); PG8_BAR; PG8_SCHED;
            } else {
            PG8_LDB(B0, 0, 0); PG8_SCHED; PG8_LDA(At, 0, 0); PG8_STAGE(PG8_SA(1, 1), a1 + hstep, voffA);
            PG8_WAIT_L(8); PG8_BAR; PG8_WAIT_L(0); PG8_MMA(0, 0, At, B0); PG8_BAR; PG8_SCHED;
            PG8_LDB(B1, 0, 1); PG8_STAGE(PG8_SB(0, 0), b2, voffB);
            PG8_BAR; PG8_WAIT_L(0); PG8_MMA(0, 1, At, B1); PG8_BAR;
            PG8_LDA(At, 0, 1); PG8_STAGE(PG8_SA(0, 0), a2, voffA);
            PG8_BAR; PG8_WAIT_L(0); PG8_MMA(1, 0, At, B0); PG8_BAR; PG8_SCHED;
            PG8_STAGE(PG8_SB(0, 1), b2 + hstep, voffB);
            PG8_WAIT_V(6); PG8_BAR; PG8_MMA(1, 1, At, B1); PG8_BAR;
            PG8_LDB(B0, 1, 0); PG8_SCHED; PG8_LDA(At, 1, 0); PG8_STAGE(PG8_SA(0, 1), a2 + hstep, voffA);
            PG8_WAIT_L(8); PG8_BAR; PG8_WAIT_L(0); PG8_MMA(0, 0, At, B0); PG8_BAR; PG8_SCHED;
            PG8_LDB(B1, 1, 1); PG8_STAGE(PG8_SB(1, 0), b3, voffB);
            PG8_BAR; PG8_WAIT_L(0); PG8_MMA(0, 1, At, B1); PG8_BAR;
            PG8_LDA(At, 1, 1); PG8_STAGE(PG8_SA(1, 0), a3, voffA);
            PG8_BAR; PG8_WAIT_L(0); PG8_MMA(1, 0, At, B0); PG8_BAR; PG8_SCHED;
            PG8_STAGE(PG8_SB(1, 1), b3 + hstep, voffB);
            PG8_WAIT_V(6); PG8_BAR; PG8_MMA(1, 1, At, B1); PG8_BAR;
            }
        }
        if constexpr (ALIGN_EPI) { if (wr == 0) PG8_BAR; }
        E(acc, cur, wr, wc, fr, fq); S.done(cur);
        if (!has_next) break;
#pragma unroll
        for (int a = 0; a < 2; ++a)
#pragma unroll
            for (int b = 0; b < 2; ++b)
#pragma unroll
                for (int m = 0; m < 4; ++m)
#pragma unroll
                    for (int n = 0; n < 2; ++n) acc[a][b][m][n] = (f32x4){0.f, 0.f, 0.f, 0.f};
        cur = nxt; cA = nA; cB = nB; ntc = ntn; ++ui;
        if constexpr (ALIGN_EPI) { if (wr == 1) PG8_BAR; }
    }
    PG8_WAIT_V(0);
    if constexpr (!ALIGN_EPI) { if (wr == 0) PG8_BAR; }
    PG8_BAR;
#undef PG8_SA
#undef PG8_SB
#undef PG8_STAGE
#undef PG8_LDA
#undef PG8_LDB
#undef PG8_MMA
#undef PG8_WAIT_V
#undef PG8_WAIT_L
#undef PG8_BAR
#undef PG8_SCHED
}

struct Gemm2 { const bf16_t* A0; const bf16_t* B0; int K0; const bf16_t* A1; const bf16_t* B1; int K1; };
template <class Epi, class Sched>
__device__ __forceinline__ void gemm_phase2(PG8_LAS unsigned char* lds, const Gemm2 g, const Sched& S, const Epi& E) {
    const int tid = threadIdx.x, wid = __builtin_amdgcn_readfirstlane(tid >> 6), lane = tid & 63, wr = wid >> 2, wc = wid & 3, fr = lane & 15, fq = lane >> 4;
    unsigned r2A[2], r2B[2], c2[2];
#pragma unroll
    for (int i = 0; i < 2; ++i) { int R, C; stage_rc(tid * 16 + i * 8192, R, C); const int Rb = (R & ~31) + perm32(R & 31); r2A[i] = (unsigned)R * 2u; r2B[i] = (unsigned)Rb * 2u; c2[i] = (unsigned)C * 2u; }
    const size_t kstep = (size_t)(BK * 2);
    const unsigned ldsw = (unsigned)wid * 1024u;
    const int aoff = lds_byte(wr * 64 + fr, fq * 8), boff = lds_byte(wc * 32 + fr, fq * 8);
#define PG8_SA(b, h) (((b) * 2 + (h)) * HTB)
#define PG8_SB(b, h) ((4 + (b) * 2 + (h)) * HTB)
#define PG8_STAGE2(bufoff, gbase, v0, v1) do { \
        __builtin_amdgcn_global_load_lds((const unsigned*)((const char*)(gbase) + (v0)), (PG8_LAS unsigned*)(lds + (bufoff) + ldsw), 16, 0, 0); \
        __builtin_amdgcn_global_load_lds((const unsigned*)((const char*)(gbase) + (v1)), (PG8_LAS unsigned*)(lds + (bufoff) + ldsw + 8192), 16, 0, 0); } while (0)
#define PG8_LDA(dst, b, h) do { _Pragma("unroll") for (int m = 0; m < 4; ++m) _Pragma("unroll") for (int k = 0; k < 2; ++k) dst[m][k] = *(const PG8_LAS bf16x8*)(lds + PG8_SA(b, h) + aoff + m * 2048 + k * 1024); } while (0)
#define PG8_LDB(dst, b, h) do { _Pragma("unroll") for (int n = 0; n < 2; ++n) _Pragma("unroll") for (int k = 0; k < 2; ++k) dst[n][k] = *(const PG8_LAS bf16x8*)(lds + PG8_SB(b, h) + boff + n * 2048 + k * 1024); } while (0)
#define PG8_MMA(ai, bj, At, Bt) do { __builtin_amdgcn_s_setprio(1); _Pragma("unroll") for (int m = 0; m < 4; ++m) _Pragma("unroll") for (int n = 0; n < 2; ++n) _Pragma("unroll") for (int k = 0; k < 2; ++k) \
        acc[ai][bj][m][n] = __builtin_amdgcn_mfma_f32_16x16x32_bf16(Bt[n][k], At[m][k], acc[ai][bj][m][n], 0, 0, 0); __builtin_amdgcn_s_setprio(0); } while (0)
#define PG8_WAIT_V(n) asm volatile("s_waitcnt vmcnt(" #n ")" ::: "memory")
#define PG8_WAIT_L(n) asm volatile("s_waitcnt lgkmcnt(" #n ")" ::: "memory")
#define PG8_BAR __builtin_amdgcn_s_barrier()
#define PG8_SCHED __builtin_amdgcn_sched_barrier(0)
#define PG8_SEG(U, SEG, PA, PB, NT, HS, VA0, VA1, VB0, VB1) do { const int K_ = (SEG) ? g.K1 : g.K0; NT = (K_ / BK) / (U).nq; HS = (size_t)HALF * K_ * 2; \
        PA = (const char*)((SEG) ? g.A1 : g.A0) + (size_t)(U).pm * 2 * HS + (size_t)((U).kq * NT) * kstep; PB = (const char*)((SEG) ? g.B1 : g.B0) + (size_t)(U).pn * 2 * HS + (size_t)((U).kq * NT) * kstep; \
        VA0 = r2A[0] * (unsigned)K_ + c2[0]; VA1 = r2A[1] * (unsigned)K_ + c2[1]; VB0 = r2B[0] * (unsigned)K_ + c2[0]; VB1 = r2B[1] * (unsigned)K_ + c2[1]; } while (0)
    Unit cur, nxt; int ui = 0, cseg = 0;
    if (!S.next(0, cur)) return;
    f32x4 acc[2][2][4][2];
#pragma unroll
    for (int a = 0; a < 2; ++a)
#pragma unroll
        for (int b = 0; b < 2; ++b)
#pragma unroll
            for (int m = 0; m < 4; ++m)
#pragma unroll
                for (int n = 0; n < 2; ++n) acc[a][b][m][n] = (f32x4){0.f, 0.f, 0.f, 0.f};
    bf16x8 At[4][2], B0[2][2], B1[2][2];
    const char *cA, *cB, *nA, *nB; int ntc, ntn; size_t hsc, hsn; unsigned vAc0, vAc1, vBc0, vBc1, vAn0, vAn1, vBn0, vBn1;
    PG8_SEG(cur, 0, cA, cB, ntc, hsc, vAc0, vAc1, vBc0, vBc1);
    PG8_STAGE2(PG8_SB(0, 0), cB, vBc0, vBc1); PG8_STAGE2(PG8_SB(0, 1), cB + hsc, vBc0, vBc1); PG8_STAGE2(PG8_SA(0, 0), cA, vAc0, vAc1); PG8_STAGE2(PG8_SA(0, 1), cA + hsc, vAc0, vAc1);
    if (wr == 1) PG8_BAR;
    PG8_WAIT_V(2); PG8_BAR;
    PG8_STAGE2(PG8_SB(1, 0), cB + kstep, vBc0, vBc1); PG8_STAGE2(PG8_SA(1, 0), cA + kstep, vAc0, vAc1); PG8_STAGE2(PG8_SB(1, 1), cB + hsc + kstep, vBc0, vBc1);
    PG8_WAIT_V(6); PG8_BAR;
    for (;;) {
        bool has_next;
        if (cseg == 0) { has_next = true; nxt = cur; PG8_SEG(cur, 1, nA, nB, ntn, hsn, vAn0, vAn1, vBn0, vBn1); }
        else { has_next = S.next(ui + 1, nxt); if (has_next) PG8_SEG(nxt, 0, nA, nB, ntn, hsn, vAn0, vAn1, vBn0, vBn1); else { nA = cA; nB = cB; ntn = ntc; hsn = hsc; vAn0 = vAc0; vAn1 = vAc1; vBn0 = vBc0; vBn1 = vBc1; } }
        for (int t = 0; t < ntc; t += 2) {
            const bool last = (t == ntc - 2);
            const char* a1 = cA + (size_t)(t + 1) * kstep;
            const char* a2 = last ? nA : cA + (size_t)(t + 2) * kstep; const char* b2 = last ? nB : cB + (size_t)(t + 2) * kstep;
            const char* a3 = a2 + kstep; const char* b3 = b2 + kstep;
            const size_t h2 = last ? hsn : hsc; const unsigned wA0 = last ? vAn0 : vAc0, wA1 = last ? vAn1 : vAc1, wB0 = last ? vBn0 : vBc0, wB1 = last ? vBn1 : vBc1;
            PG8_LDB(B0, 0, 0); PG8_LDB(B1, 0, 1); PG8_SCHED; PG8_LDA(At, 0, 0); PG8_STAGE2(PG8_SA(1, 1), a1 + hsc, vAc0, vAc1);
            PG8_WAIT_V(8); PG8_WAIT_L(0); PG8_BAR; PG8_MMA(0, 0, At, B0); PG8_MMA(0, 1, At, B1); PG8_BAR; PG8_SCHED;
            PG8_LDA(At, 0, 1); PG8_STAGE2(PG8_SB(0, 0), b2, wB0, wB1); PG8_STAGE2(PG8_SB(0, 1), b2 + h2, wB0, wB1); PG8_STAGE2(PG8_SA(0, 0), a2, wA0, wA1);
            PG8_WAIT_V(8); PG8_WAIT_L(0); PG8_BAR; PG8_MMA(1, 0, At, B0); PG8_MMA(1, 1, At, B1); PG8_BAR; PG8_SCHED;
            PG8_LDB(B0, 1, 0); PG8_LDB(B1, 1, 1); PG8_SCHED; PG8_LDA(At, 1, 0); PG8_STAGE2(PG8_SA(0, 1), a2 + h2, wA0, wA1);
            PG8_WAIT_V(8); PG8_WAIT_L(0); PG8_BAR; PG8_MMA(0, 0, At, B0); PG8_MMA(0, 1, At, B1); PG8_BAR; PG8_SCHED;
            PG8_LDA(At, 1, 1); PG8_STAGE2(PG8_SB(1, 0), b3, wB0, wB1); PG8_STAGE2(PG8_SB(1, 1), b3 + h2, wB0, wB1); PG8_STAGE2(PG8_SA(1, 0), a3, wA0, wA1);
            PG8_WAIT_V(8); PG8_WAIT_L(0); PG8_BAR; PG8_MMA(1, 0, At, B0); PG8_MMA(1, 1, At, B1); PG8_BAR; PG8_SCHED;
        }
        if (wr == 0) PG8_BAR;
        if (cseg == 0) E.mid(acc, cur, wr, wc, fr, fq); else E(acc, cur, wr, wc, fr, fq);
        if (!has_next) break;
        if (cseg == 1) {
#pragma unroll
            for (int a = 0; a < 2; ++a)
#pragma unroll
                for (int b = 0; b < 2; ++b)
#pragma unroll
                    for (int m = 0; m < 4; ++m)
#pragma unroll
                        for (int n = 0; n < 2; ++n) acc[a][b][m][n] = (f32x4){0.f, 0.f, 0.f, 0.f};
            cur = nxt; ++ui; }
        cseg ^= 1; cA = nA; cB = nB; ntc = ntn; hsc = hsn; vAc0 = vAn0; vAc1 = vAn1; vBc0 = vBn0; vBc1 = vBn1;
        if (wr == 1) PG8_BAR;
    }
    PG8_WAIT_V(0);
    PG8_BAR;
#undef PG8_SA
#undef PG8_SB
#undef PG8_STAGE2
#undef PG8_LDA
#undef PG8_LDB
#undef PG8_MMA
#undef PG8_WAIT_V
#undef PG8_WAIT_L
#undef PG8_BAR
#undef PG8_SCHED
#undef PG8_SEG
}
}

#define EPI_FOR3 _Pragma("unroll") for (int ai = 0; ai < 2; ++ai) _Pragma("unroll") for (int m = 0; m < 4; ++m) _Pragma("unroll") for (int bj = 0; bj < 2; ++bj)

__device__ __forceinline__ u32x4 pack8(f32x4 v0, f32x4 v1) { u32x4 w; w.x = cvt_pk_bf16(v0[0], v0[1]); w.y = cvt_pk_bf16(v0[2], v0[3]); w.z = cvt_pk_bf16(v1[0], v1[1]); w.w = cvt_pk_bf16(v1[2], v1[3]); return w; }

struct EpiIn {
    static constexpr bool PERM = true, AFTER_DRAIN = false;
    unsigned char* ws; float* out; const float* dt_bias;
    template <int ACT> __device__ __forceinline__ void store_act(const f32x4 (&acc)[2][2][4][2], bf16* base, int ld, int rbase, int col0) const {
        EPI_FOR3 { f32x4 v0 = acc[ai][bj][m][0], v1 = acc[ai][bj][m][1];
            if (ACT == 1) { _Pragma("unroll") for (int e = 0; e < 4; ++e) { v0[e] = silu_f(v0[e]); v1[e] = silu_f(v1[e]); } }
            if (ACT == 2) { _Pragma("unroll") for (int e = 0; e < 4; ++e) { v0[e] = sigm_f(v0[e]); v1[e] = sigm_f(v1[e]); } }
            *(GAS u32x4*)(base + (size_t)(rbase + ai * 128 + m * 16) * ld + col0 + bj * 128) = pack8(v0, v1); }
    }
    __device__ __forceinline__ void operator()(const f32x4 (&acc)[2][2][4][2], const pg8::Unit& u, int wr, int wc, int fr, int fq) const {
        const int pn = u.pn, rbase = u.pm * 256 + wr * 64 + fr, cl = wc * 32 + 8 * fq;
        if (pn < 32) { store_act<1>(acc, (bf16*)(ws + WS_ZM), DI, rbase, pn * 256 + cl); }
        else if (pn < 72) {
            const int c0 = (pn - 32) * 256 + cl;
            store_act<0>(acc, (bf16*)(ws + WS_XBC), CD, rbase, c0);
            if (fr >= 13 && (u.pm >= 64 || ((u.pm & 31) == 31 && wr == 1))) {
#pragma unroll
                for (int ai = 0; ai < 2; ++ai) { if (u.pm < 64 && ai == 0) continue;
                    const int row = rbase + ai * 128 + 48; float* dst;
                    if (row < MP) dst = out + O_CP + (size_t)((row >> 13) * 3 + ((row & 8191) - 8189)) * CD; else dst = out + O_CS + (size_t)(((row - MP) >> 6) * 3 + ((row & 63) - 61)) * CD;
#pragma unroll
                    for (int bj = 0; bj < 2; ++bj) { *(GAS f32x4*)(dst + c0 + bj * 128) = acc[ai][bj][3][0]; *(GAS f32x4*)(dst + c0 + bj * 128 + 4) = acc[ai][bj][3][1]; } }
            }
        }
        else if (pn < 96) {
            const int kind = pn < 88 ? 0 : (pn < 92 ? 1 : 2);
            const int c0 = (pn - (kind == 0 ? 72 : (kind == 1 ? 88 : 92))) * 256 + cl;
            const float* rope = (const float*)(ws + WS_ROPE);
            EPI_FOR3 { f32x4 v0 = acc[ai][bj][m][0], v1 = acc[ai][bj][m][1];
                const int row = rbase + ai * 128 + m * 16;
                if (kind < 2 && (wc & 1) == 0) {
                    f32x4 p0, p1;
#pragma unroll
                    for (int e = 0; e < 4; ++e) { p0[e] = __shfl_xor(v0[e], 16); p1[e] = __shfl_xor(v1[e], 16); }
                    if (fq < 2) {
                        const int pos = row < MP ? (row & 8191) : 2048 + (row & 63);
                        const f32x4 c0v = *(const GAS f32x4*)(rope + pos * 16), c1v = *(const GAS f32x4*)(rope + pos * 16 + 4), s0v = *(const GAS f32x4*)(rope + pos * 16 + 8), s1v = *(const GAS f32x4*)(rope + pos * 16 + 12);
                        const float sg = fq == 0 ? -1.f : 1.f;
                        v0 = v0 * c0v + sg * (p0 * s0v); v1 = v1 * c1v + sg * (p1 * s1v);
                    }
                }
                if (kind == 0) { v0 = v0 * QSCALE; v1 = v1 * QSCALE; *(GAS u32x4*)((bf16*)(ws + WS_Q) + (size_t)row * D + c0 + bj * 128) = pack8(v0, v1); }
                else {
                    float* fo; bf16* bo;
                    if (row < MP) { fo = out + (kind == 1 ? O_KP : O_VP) + (size_t)row * 1024; bo = (bf16*)(ws + (kind == 1 ? WS_KB : WS_VB)) + (size_t)row * 1024; }
                    else { const int rs = row - MP; fo = out + (kind == 1 ? O_KS : O_VS) + (size_t)rs * 1024; bo = (bf16*)(ws + (kind == 1 ? WS_KS : WS_VS)) + (size_t)((rs >> 6) * 2112 + 2048 + (rs & 63)) * 1024; }
                    *(GAS f32x4*)(fo + c0 + bj * 128) = v0; *(GAS f32x4*)(fo + c0 + bj * 128 + 4) = v1;
                    *(GAS u32x4*)(bo + c0 + bj * 128) = pack8(v0, v1);
                }
            }
        }
        else if (pn < 112) { store_act<1>(acc, (bf16*)(ws + WS_ZA), D, rbase, (pn - 96) * 256 + cl); }
        else if (pn < 128) { store_act<2>(acc, (bf16*)(ws + WS_GM), D, rbase, (pn - 112) * 256 + cl); }
        else if (pn < 144) { store_act<2>(acc, (bf16*)(ws + WS_GA), D, rbase, (pn - 128) * 256 + cl); }
        else {
            float* DT = (float*)(ws + WS_DT);
            const f32x4 b0 = *(const GAS f32x4*)(dt_bias + cl), b1 = *(const GAS f32x4*)(dt_bias + cl + 4);
#pragma unroll
            for (int ai = 0; ai < 2; ++ai)
#pragma unroll
                for (int m = 0; m < 4; ++m) { f32x4 v0 = acc[ai][0][m][0] + b0, v1 = acc[ai][0][m][1] + b1;
#pragma unroll
                    for (int e = 0; e < 4; ++e) { v0[e] = v0[e] > 20.f ? v0[e] : log1pf(expf(v0[e])); v1[e] = v1[e] > 20.f ? v1[e] : log1pf(expf(v1[e])); }
                    float* dst = DT + (size_t)(rbase + ai * 128 + m * 16) * NH + cl; *(GAS f32x4*)dst = v0; *(GAS f32x4*)(dst + 4) = v1; }
        }
    }
};
__device__ __forceinline__ void atomic_add8(float* p, f32x4 v0, f32x4 v1) {
#pragma unroll
    for (int e = 0; e < 4; ++e) { unsafeAtomicAdd(p + e, v0[e]); unsafeAtomicAdd(p + 4 + e, v1[e]); }
}
struct EpiG1 {
    static constexpr bool PERM = true, AFTER_DRAIN = false;
    const bf16* GM; float* T1; float* TS;
    __device__ __forceinline__ void operator()(const f32x4 (&acc)[2][2][4][2], const pg8::Unit& u, int wr, int wc, int fr, int fq) const {
        const int rbase = u.pm * 256 + wr * 64 + fr, c0 = u.pn * 256 + wc * 32 + 8 * fq;
        u32x4 gv[2][4][2];
        EPI_FOR3 gv[ai][m][bj] = *(const GAS u32x4*)(GM + (size_t)(rbase + ai * 128 + m * 16) * D + c0 + bj * 128);
        float* dst = (u.nq > 1) ? TS + (size_t)u.kq * MS * D - (size_t)MP * D : T1;
        EPI_FOR3 { const size_t off = (size_t)(rbase + ai * 128 + m * 16) * D + c0 + bj * 128; const u32x4 g = gv[ai][m][bj];
            f32x4 v0 = acc[ai][bj][m][0], v1 = acc[ai][bj][m][1];
            v0[0] *= bf_lo(g.x); v0[1] *= bf_hi(g.x); v0[2] *= bf_lo(g.y); v0[3] *= bf_hi(g.y); v1[0] *= bf_lo(g.z); v1[1] *= bf_hi(g.z); v1[2] *= bf_lo(g.w); v1[3] *= bf_hi(g.w);
            *(GAS f32x4*)(dst + off) = v0; *(GAS f32x4*)(dst + off + 4) = v1; }
    }
};
struct EpiG2 {
    static constexpr bool PERM = true, AFTER_DRAIN = false;
    const bf16* GA; const float* T1; bf16* MG; float* TS;
    __device__ __forceinline__ void operator()(const f32x4 (&acc)[2][2][4][2], const pg8::Unit& u, int wr, int wc, int fr, int fq) const {
        const int rbase = u.pm * 256 + wr * 64 + fr, c0 = u.pn * 256 + wc * 32 + 8 * fq;
        const bool sp = u.nq > 1; float* ts = TS + (size_t)(4 + u.kq) * MS * D - (size_t)MP * D;
#pragma unroll
        for (int am = 0; am < 4; ++am) { const int ai = am >> 1, mh = (am & 1) * 2; u32x4 gv[4][2]; f32x4 t0[4][2], t1[4][2];
#pragma unroll
            for (int m = mh; m < mh + 2; ++m)
#pragma unroll
                for (int bj = 0; bj < 2; ++bj) { const size_t off = (size_t)(rbase + ai * 128 + m * 16) * D + c0 + bj * 128; gv[m][bj] = *(const GAS u32x4*)(GA + off);
                    if (!sp) { t0[m][bj] = *(const GAS f32x4*)(T1 + off); t1[m][bj] = *(const GAS f32x4*)(T1 + off + 4); } else { t0[m][bj] = (f32x4){0.f, 0.f, 0.f, 0.f}; t1[m][bj] = (f32x4){0.f, 0.f, 0.f, 0.f}; } }
#pragma unroll
            for (int m = mh; m < mh + 2; ++m)
#pragma unroll
                for (int bj = 0; bj < 2; ++bj) { const size_t off = (size_t)(rbase + ai * 128 + m * 16) * D + c0 + bj * 128; const u32x4 g = gv[m][bj];
                    f32x4 v0 = acc[ai][bj][m][0], v1 = acc[ai][bj][m][1];
                    v0[0] = t0[m][bj][0] + v0[0] * bf_lo(g.x); v0[1] = t0[m][bj][1] + v0[1] * bf_hi(g.x); v0[2] = t0[m][bj][2] + v0[2] * bf_lo(g.y); v0[3] = t0[m][bj][3] + v0[3] * bf_hi(g.y);
                    v1[0] = t1[m][bj][0] + v1[0] * bf_lo(g.z); v1[1] = t1[m][bj][1] + v1[1] * bf_hi(g.z); v1[2] = t1[m][bj][2] + v1[2] * bf_lo(g.w); v1[3] = t1[m][bj][3] + v1[3] * bf_hi(g.w);
                    if (sp) { *(GAS f32x4*)(ts + off) = v0; *(GAS f32x4*)(ts + off + 4) = v1; } else *(GAS u32x4*)(MG + off) = pack8(v0, v1); } }
    }
};
struct EpiG12 {
    static constexpr bool PERM = true, AFTER_DRAIN = false;
    const bf16* GM; const bf16* GA; bf16* MG; float* TS;
    __device__ __forceinline__ void mid(f32x4 (&acc)[2][2][4][2], const pg8::Unit& u, int wr, int wc, int fr, int fq) const {
        asm volatile("" : "+v"(fr), "+v"(fq));
        const int rbase = u.pm * 256 + wr * 64 + fr, c0 = u.pn * 256 + wc * 32 + 8 * fq;
#pragma unroll
        for (int ai = 0; ai < 2; ++ai) { u32x4 gm[4][2], ga[4][2];
#pragma unroll
            for (int m = 0; m < 4; ++m)
#pragma unroll
                for (int bj = 0; bj < 2; ++bj) { const size_t off = (size_t)(rbase + ai * 128 + m * 16) * D + c0 + bj * 128; gm[m][bj] = *(const GAS u32x4*)(GM + off); ga[m][bj] = *(const GAS u32x4*)(GA + off); }
#pragma unroll
            for (int m = 0; m < 4; ++m)
#pragma unroll
                for (int bj = 0; bj < 2; ++bj) { const u32x4 a = gm[m][bj], b = ga[m][bj];
#define RAT(x, y) ((x) * __builtin_amdgcn_rcpf(fmaxf((y), 1e-20f)))
                    acc[ai][bj][m][0][0] *= RAT(bf_lo(a.x), bf_lo(b.x)); acc[ai][bj][m][0][1] *= RAT(bf_hi(a.x), bf_hi(b.x)); acc[ai][bj][m][0][2] *= RAT(bf_lo(a.y), bf_lo(b.y)); acc[ai][bj][m][0][3] *= RAT(bf_hi(a.y), bf_hi(b.y));
                    acc[ai][bj][m][1][0] *= RAT(bf_lo(a.z), bf_lo(b.z)); acc[ai][bj][m][1][1] *= RAT(bf_hi(a.z), bf_hi(b.z)); acc[ai][bj][m][1][2] *= RAT(bf_lo(a.w), bf_lo(b.w)); acc[ai][bj][m][1][3] *= RAT(bf_hi(a.w), bf_hi(b.w));
#undef RAT
                } }
    }
    __device__ __forceinline__ void operator()(const f32x4 (&acc)[2][2][4][2], const pg8::Unit& u, int wr, int wc, int fr, int fq) const {
        asm volatile("" : "+v"(fr), "+v"(fq));
        const int rbase = u.pm * 256 + wr * 64 + fr, c0 = u.pn * 256 + wc * 32 + 8 * fq;
        const bool sp = u.nq > 1; float* ts = TS + (size_t)u.kq * MS * D - (size_t)MP * D;
        u32x4 gv[2][4][2];
        EPI_FOR3 gv[ai][m][bj] = *(const GAS u32x4*)(GA + (size_t)(rbase + ai * 128 + m * 16) * D + c0 + bj * 128);
        EPI_FOR3 { const size_t off = (size_t)(rbase + ai * 128 + m * 16) * D + c0 + bj * 128; const u32x4 g = gv[ai][m][bj];
            f32x4 v0 = acc[ai][bj][m][0], v1 = acc[ai][bj][m][1];
            v0[0] *= bf_lo(g.x); v0[1] *= bf_hi(g.x); v0[2] *= bf_lo(g.y); v0[3] *= bf_hi(g.y); v1[0] *= bf_lo(g.z); v1[1] *= bf_hi(g.z); v1[2] *= bf_lo(g.w); v1[3] *= bf_hi(g.w);
            if (sp) { *(GAS f32x4*)(ts + off) = v0; *(GAS f32x4*)(ts + off + 4) = v1; } else *(GAS u32x4*)(MG + off) = pack8(v0, v1); }
    }
};
struct EpiOut {
    static constexpr bool PERM = true, AFTER_DRAIN = false;
    const float* mod; bf16* DLT; float* PS;
    __device__ __forceinline__ void operator()(const f32x4 (&acc)[2][2][4][2], const pg8::Unit& u, int wr, int wc, int fr, int fq) const {
        const int rbase = u.pm * 256 + wr * 64 + fr, c0 = u.pn * 256 + wc * 32 + 8 * fq; const bool sp = u.nq > 1;
#pragma unroll
        for (int ai = 0; ai < 2; ++ai) { const int row0 = rbase + ai * 128; const int bi = row0 < MP ? (row0 >> 13) : 2 + ((row0 - MP) >> 6);
            const float* gp = mod + (size_t)bi * 12288 + 8192 + c0;
            f32x4 g0[2], g1[2];
#pragma unroll
            for (int bj = 0; bj < 2; ++bj) { g0[bj] = *(const GAS f32x4*)(gp + bj * 128); g1[bj] = *(const GAS f32x4*)(gp + bj * 128 + 4); }
            float* yb = PS + (size_t)u.kq * MS * D + (size_t)(row0 - MP) * D; bf16* xb = DLT + (size_t)row0 * D;
#pragma unroll
            for (int m = 0; m < 4; ++m)
#pragma unroll
                for (int bj = 0; bj < 2; ++bj) { const size_t o_ = (size_t)(m * 16) * D + c0 + bj * 128; const f32x4 r0 = g0[bj] * acc[ai][bj][m][0], r1 = g1[bj] * acc[ai][bj][m][1];
                    if (sp) { *(GAS f32x4*)(yb + o_) = r0; *(GAS f32x4*)(yb + o_ + 4) = r1; } else *(GAS u32x4*)(xb + o_) = pack8(r0, r1); } }
    }
};

#define XB_TMO      128
#define XB_XCNT(j)  (256  + 64 * (j))
#define XB_XSUB(j)  (1280 + 64 * (j))
#define XB_XGEN(j)  (2304 + 64 * (j))
#define XB_TOP      3328
#define XB_TOPGEN   3392
#define XCD_BAR_WORDS 3456
#define XB_SPIN_CAP (1u << 18)
__device__ __forceinline__ unsigned xb_ld(unsigned* p)              { return __hip_atomic_load(p, __ATOMIC_RELAXED, __HIP_MEMORY_SCOPE_AGENT); }
__device__ __forceinline__ unsigned xb_add(unsigned* p, unsigned v) { return __hip_atomic_fetch_add(p, v, __ATOMIC_RELAXED, __HIP_MEMORY_SCOPE_AGENT); }
__device__ __forceinline__ unsigned xb_xcc_id() { return (unsigned)__builtin_amdgcn_s_getreg((3 << 11) | 20) & 0xFu; }
#define XB_SPIN(cond, bar) do { unsigned _sp = 0; while (cond) { __builtin_amdgcn_s_sleep(1); \
    if ((++_sp & 255u) == 0u) { if (xb_ld(&(bar)[XB_TMO])) break; if (_sp > XB_SPIN_CAP) { atomicAdd(&(bar)[XB_TMO], 1u); break; } } } } while (0)
struct XcdBarrier { unsigned* bar; unsigned x; volatile LAS unsigned* st; };
__device__ __forceinline__ XcdBarrier xcd_barrier_post(unsigned* bar, volatile LAS unsigned* st) {
    XcdBarrier b; b.bar = bar; b.x = xb_xcc_id(); b.st = st;
    if (threadIdx.x == 0) (void)xb_add(&bar[XB_XCNT(b.x)], 1u);
    return b;
}
__device__ __forceinline__ void xcd_barrier_complete(unsigned* bar, unsigned x, unsigned& nloc, unsigned& nx) {
    const unsigned G = gridDim.x * gridDim.y * gridDim.z;
    unsigned sum, cnt, mine, sp = 0u;
    for (;;) {
        sum = 0u; cnt = 0u; mine = 0u;
#pragma unroll
        for (unsigned j = 0; j < 16; ++j) { const unsigned c = xb_ld(&bar[XB_XCNT(j)]); sum += c; cnt += (c > 0u) ? 1u : 0u; mine = (j == x) ? c : mine; }
        if (sum == G) break;
        __builtin_amdgcn_s_sleep(1);
        if ((++sp & 255u) == 0u) { if (xb_ld(&bar[XB_TMO])) break; if (sp > XB_SPIN_CAP) { atomicAdd(&bar[XB_TMO], 1u); break; } }
    }
    nloc = mine > 0u ? mine : 1u; nx = cnt > 0u ? cnt : 1u;
}
__device__ __forceinline__ void xcd_barrier(const XcdBarrier& b) {
    asm volatile("s_waitcnt vmcnt(0)" ::: "memory");
    __syncthreads();
    if (threadIdx.x == 0) {
        unsigned* bar = b.bar;
        __builtin_amdgcn_s_waitcnt(0);
        unsigned nloc = b.st[0], nx = b.st[1];
        if (nloc == 0u) { xcd_barrier_complete(bar, b.x, nloc, nx); b.st[0] = nloc; b.st[1] = nx; }
        const unsigned old = xb_add(&bar[XB_XSUB(b.x)], 1u);
        const unsigned gen = old / nloc;
        if (old + 1u == (gen + 1u) * nloc) {
            __builtin_amdgcn_fence(__ATOMIC_RELEASE, "agent");
            asm volatile("s_waitcnt vmcnt(0)" ::: "memory");
            const unsigned og = xb_add(&bar[XB_TOP], 1u);
            const unsigned tg = og / nx;
            if (og + 1u == (tg + 1u) * nx) xb_add(&bar[XB_TOPGEN], 1u);
            else XB_SPIN(xb_ld(&bar[XB_TOPGEN]) == tg, bar);
            __builtin_amdgcn_fence(__ATOMIC_ACQUIRE, "agent");
            xb_add(&bar[XB_XGEN(b.x)], 1u);
            asm volatile("s_waitcnt vmcnt(0)" ::: "memory");
        } else {
            XB_SPIN(xb_ld(&bar[XB_XGEN(b.x)]) == gen, bar);
            __builtin_amdgcn_fence(__ATOMIC_ACQUIRE, "agent");
            asm volatile("s_waitcnt vmcnt(0)" ::: "memory");
        }
    }
    __syncthreads();
}

struct Args { const float* in[27]; float* out; unsigned char* ws; int ph_lo, ph_hi; };
enum { I_XP = 0, I_XS, I_CK, I_CV, I_SCONV, I_SSSM, I_CP, I_CS, I_WADA, I_BADA, I_NORMW, I_WIN, I_CONVW, I_CONVB, I_DTB, I_ALOG, I_DSKIP, I_MNW, I_LQ1, I_LK1, I_LQ2, I_LK2, I_ANW, I_WPM, I_WPA, I_WOUT, I_FNW };

__device__ __forceinline__ void p0_transpose_item(const float* W, int K, int N, bf16* WT, int row_off, LAS float* scr, int kb, int nb, int lane) {
    const int k0 = 64 * kb, n0 = 32 * nb;
#pragma unroll 8
    for (int i = 0; i < 32; ++i) { const int kk = 2 * i + (lane >> 5); scr[kk * 33 + (lane & 31)] = *(const GAS float*)(W + (size_t)(k0 + kk) * N + n0 + (lane & 31)); }
    asm volatile("s_waitcnt lgkmcnt(0)" ::: "memory");
    const int c = lane & 7;
#pragma unroll
    for (int j = 0; j < 4; ++j) { const int n = (lane >> 3) + 8 * j; const LAS float* s = scr + (8 * c) * 33 + n;
        u32x4 o; o.x = cvt_pk_bf16(s[0 * 33], s[1 * 33]); o.y = cvt_pk_bf16(s[2 * 33], s[3 * 33]); o.z = cvt_pk_bf16(s[4 * 33], s[5 * 33]); o.w = cvt_pk_bf16(s[6 * 33], s[7 * 33]);
        *(GAS u32x4*)(WT + (size_t)(row_off + n0 + n) * K + k0 + 8 * c) = o; }
    asm volatile("s_waitcnt lgkmcnt(0)" ::: "memory");
}
__device__ __forceinline__ void p0_transpose_tile(const float* W, int K, int N, bf16* WT, int row_off, int kb, int nb, int lane) {
    const int k0 = 64 * kb + 16 * (lane >> 4), n0 = 64 * nb + 4 * (lane & 15);
    f32x4 v[16];
    const float* src = W + (size_t)k0 * N + n0;
#pragma unroll
    for (int i = 0; i < 16; ++i) v[i] = __builtin_nontemporal_load((const GAS f32x4*)(src + (size_t)i * N));
    bf16* dst = WT + (size_t)(row_off + n0) * K + k0;
#pragma unroll
    for (int e = 0; e < 4; ++e)
#pragma unroll
        for (int h = 0; h < 2; ++h) { u32x4 o; o.x = cvt_pk_bf16(v[8 * h][e], v[8 * h + 1][e]); o.y = cvt_pk_bf16(v[8 * h + 2][e], v[8 * h + 3][e]); o.z = cvt_pk_bf16(v[8 * h + 4][e], v[8 * h + 5][e]); o.w = cvt_pk_bf16(v[8 * h + 6][e], v[8 * h + 7][e]);
            *(GAS u32x4*)(dst + (size_t)e * K + 8 * h) = o; }
}
__device__ __forceinline__ void phase_prologue(const Args& a, LAS unsigned char* lds, int tid, int bx, int G, bool do_mod = true) {
    const int lane = tid & 63, wave = __builtin_amdgcn_readfirstlane(tid >> 6);
    const int gw = bx * 8 + wave, NGW = G * 8, gt = bx * 512 + tid, NGT = G * 512;
    if (do_mod) for (int task = bx; task < 48; task += G) {
        const int ks = task / 6, cg = task % 6, k0 = ks * 512;
        LAS float* sc = (LAS float*)lds;
        for (int i = tid; i < 18 * 512; i += 512) { const int b = i >> 9, k = i & 511; const float c = (b < 2) ? a.in[I_CP][b * D + k0 + k] : a.in[I_CS][(b - 2) * D + k0 + k]; sc[k * 20 + b] = silu_f(c); }
        __syncthreads();
        const int col = cg * 2048 + wave * 256 + lane * 4;
        f32x4 acc[18];
#pragma unroll
        for (int b = 0; b < 18; ++b) acc[b] = (f32x4){0.f, 0.f, 0.f, 0.f};
        const float* wp = a.in[I_WADA] + (size_t)k0 * 12288 + col;
#pragma unroll 8
        for (int k = 0; k < 512; ++k) { const f32x4 w = __builtin_nontemporal_load((const GAS f32x4*)(wp + (size_t)k * 12288));
            const LAS f32x4* s4 = (const LAS f32x4*)(sc + k * 20);
            const f32x4 s0 = s4[0], s1 = s4[1], s2 = s4[2], s3 = s4[3], s4v = s4[4];
            acc[0] += s0[0] * w; acc[1] += s0[1] * w; acc[2] += s0[2] * w; acc[3] += s0[3] * w; acc[4] += s1[0] * w; acc[5] += s1[1] * w; acc[6] += s1[2] * w; acc[7] += s1[3] * w;
            acc[8] += s2[0] * w; acc[9] += s2[1] * w; acc[10] += s2[2] * w; acc[11] += s2[3] * w; acc[12] += s3[0] * w; acc[13] += s3[1] * w; acc[14] += s3[2] * w; acc[15] += s3[3] * w;
            acc[16] += s4v[0] * w; acc[17] += s4v[1] * w; }
        float* mod = (float*)(a.ws + WS_MOD);
        f32x4 bias = (f32x4){0.f, 0.f, 0.f, 0.f}; if (ks == 0) bias = *(const GAS f32x4*)(a.in[I_BADA] + col);
#pragma unroll
        for (int b = 0; b < 18; ++b)
#pragma unroll
            for (int e = 0; e < 4; ++e) unsafeAtomicAdd(mod + (size_t)b * 12288 + col + e, acc[b][e] + bias[e]);
        __syncthreads();
    }
    { float* rope = (float*)(a.ws + WS_ROPE);
      const float invf[8] = {1.0f, 0.1939227432012558f, 0.03760603070259094f, 0.007292664609849453f, 0.0014142135623842478f, 0.00027424818836152554f, 5.3182957344688475e-05f, 1.0313385246263351e-05f};
      for (int i = gt; i < 8192 * 8; i += NGT) { const int pos = i >> 3, k = i & 7; float inv = invf[0];
#pragma unroll
          for (int q = 1; q < 8; ++q) inv = (k == q) ? invf[q] : inv;
          const float ang = (float)pos * inv; const double ad = (double)ang; const double nrev = __builtin_rint(ad * 0.15915494309189535); const float r = (float)(ad - nrev * 6.283185307179586);
          rope[pos * 16 + k] = __cosf(r); rope[pos * 16 + 8 + k] = __sinf(r); } }
    { constexpr int NB_IN = 36992 / 64, I_IN = 64 * NB_IN, I_PM = 128 * 64, I_PA = 64 * 64, I_OUT = 64 * 64, NIT = I_IN + I_PM + I_PA + I_OUT;
      for (int it = gw; it < NIT; it += NGW) { int r = it;
          if (r < I_IN) { const int kb = r / NB_IN, nb = r % NB_IN, n0 = nb * 64; const int off = n0 < 18432 ? 0 : (n0 < 18560 ? 36864 - 18432 : -128);
              p0_transpose_tile(a.in[I_WIN], D, 36992, (bf16*)(a.ws + WS_WIN), off, kb, nb, lane); continue; } r -= I_IN;
          if (r < I_PM) { p0_transpose_tile(a.in[I_WPM], DI, D, (bf16*)(a.ws + WS_WPM), 0, r / 64, r % 64, lane); continue; } r -= I_PM;
          if (r < I_PA) { p0_transpose_tile(a.in[I_WPA], D, D, (bf16*)(a.ws + WS_WPA), 0, r / 64, r % 64, lane); continue; } r -= I_PA;
          p0_transpose_tile(a.in[I_WOUT], D, D, (bf16*)(a.ws + WS_WOUT), 0, r / 64, r % 64, lane); }
      u32x4* padp = (u32x4*)((bf16*)(a.ws + WS_WIN) + (size_t)36992 * D);
      for (int i = gt; i < 128 * D / 8; i += NGT) *(GAS u32x4*)(padp + i) = (u32x4){0u, 0u, 0u, 0u}; }
    for (int i = gt; i < 2 * 4194304; i += NGT) { const int which = i >= 4194304, j = which ? i - 4194304 : i; const size_t src = (size_t)j * 8; const int b = j >> 18;
        const float* sp = a.in[which ? I_CV : I_CK] + src; const f32x4 v0 = *(const GAS f32x4*)sp, v1 = *(const GAS f32x4*)(sp + 4);
        *(GAS u32x4*)((bf16*)(a.ws + (which ? WS_VS : WS_KS)) + src + (size_t)b * 65536) = pack8(v0, v1); }
}
__device__ __forceinline__ void phase_h(const Args& a, int tid, int bx, int G, size_t hoff = WS_H) {
    const int lane = tid & 63, wave = tid >> 6, gw = bx * 8 + wave, NGW = G * 8;
    const float* mod = (const float*)(a.ws + WS_MOD); bf16* H = (bf16*)(a.ws + hoff);
    constexpr int NPAIR = M / 2; const int nfull = (NPAIR / NGW) * NGW, nrem = NPAIR - nfull;
    const int rstep = nrem > 0 ? NGW / nrem : 1;
    for (int i = 0;; ++i) {
        int rp;
        if ((i + 1) * NGW <= nfull) rp = i * NGW + gw;
        else { if (nrem == 0 || gw % rstep != 0 || gw / rstep >= nrem) break; rp = nfull + gw / rstep; }
        const int row = 2 * rp;
        const float* xr = row < MP ? a.in[I_XP] + (size_t)row * D : a.in[I_XS] + (size_t)(row - MP) * D; const int bi = row < MP ? (row >> 13) : 2 + ((row - MP) >> 6);
        f32x4 v[2][8][2]; float s0 = 0.f, s1 = 0.f;
#pragma unroll
        for (int q = 0; q < 2; ++q)
#pragma unroll
            for (int j = 0; j < 8; ++j) { v[q][j][0] = *(const GAS f32x4*)(xr + q * D + 8 * (64 * j + lane)); v[q][j][1] = *(const GAS f32x4*)(xr + q * D + 8 * (64 * j + lane) + 4); }
#pragma unroll
        for (int j = 0; j < 8; ++j) {
            s0 += (v[0][j][0][0] * v[0][j][0][0] + v[0][j][0][1] * v[0][j][0][1]) + (v[0][j][0][2] * v[0][j][0][2] + v[0][j][0][3] * v[0][j][0][3]) + (v[0][j][1][0] * v[0][j][1][0] + v[0][j][1][1] * v[0][j][1][1]) + (v[0][j][1][2] * v[0][j][1][2] + v[0][j][1][3] * v[0][j][1][3]);
            s1 += (v[1][j][0][0] * v[1][j][0][0] + v[1][j][0][1] * v[1][j][0][1]) + (v[1][j][0][2] * v[1][j][0][2] + v[1][j][0][3] * v[1][j][0][3]) + (v[1][j][1][0] * v[1][j][1][0] + v[1][j][1][1] * v[1][j][1][1]) + (v[1][j][1][2] * v[1][j][1][2] + v[1][j][1][3] * v[1][j][1][3]); }
        const float rstd0 = 1.f / sqrtf(wave_sum(s0) * (1.f / D) + EPS), rstd1 = 1.f / sqrtf(wave_sum(s1) * (1.f / D) + EPS);
        const float* sh = mod + (size_t)bi * 12288; const float* scl = sh + 4096; const float* nw = a.in[I_NORMW];
#pragma unroll
        for (int j = 0; j < 8; ++j) { const int c = 8 * (64 * j + lane);
#pragma unroll
            for (int h = 0; h < 2; ++h) { const f32x4 w = *(const GAS f32x4*)(nw + c + 4 * h), sc = *(const GAS f32x4*)(scl + c + 4 * h), sf = *(const GAS f32x4*)(sh + c + 4 * h);
                const f32x4 m = w * (1.f + sc);
                v[0][j][h] = v[0][j][h] * rstd0 * m + sf; v[1][j][h] = v[1][j][h] * rstd1 * m + sf; }
            *(GAS u32x4*)(H + (size_t)row * D + c) = pack8(v[0][j][0], v[0][j][1]); *(GAS u32x4*)(H + (size_t)(row + 1) * D + c) = pack8(v[1][j][0], v[1][j][1]); }
        if ((i + 1) * NGW > nfull) break;
    }
}
__device__ __forceinline__ void phase_conv(const Args& a, int tid, int bx, int G) {
    const int lane = tid & 63, wave = tid >> 6, gw = bx * 8 + wave, NGW = G * 8;
    const bf16* XBC = (const bf16*)(a.ws + WS_XBC);
    for (int u = gw; u < 272 * 80; u += NGW) {
        const int ch = u / 80, cb = u % 80, c = cb * 128 + 2 * lane, m0 = ch * 64;
        const f32x2 w0 = *(const GAS f32x2*)(a.in[I_CONVW] + c), w1 = *(const GAS f32x2*)(a.in[I_CONVW] + CD + c), w2 = *(const GAS f32x2*)(a.in[I_CONVW] + 2 * CD + c), w3 = *(const GAS f32x2*)(a.in[I_CONVW] + 3 * CD + c), bias = *(const GAS f32x2*)(a.in[I_CONVB] + c);
        f32x2 x0 = {0.f, 0.f}, x1 = {0.f, 0.f}, x2 = {0.f, 0.f};
        if (ch >= 256) { const float* sp = a.in[I_SCONV] + (size_t)(ch - 256) * 3 * CD + c; x0 = *(const GAS f32x2*)sp; x1 = *(const GAS f32x2*)(sp + CD); x2 = *(const GAS f32x2*)(sp + 2 * CD); }
        else if ((ch & 127) != 0) { const bf16* pp = XBC + (size_t)(m0 - 3) * CD + c; const unsigned r0 = *(const GAS unsigned*)pp, r1 = *(const GAS unsigned*)(pp + CD), r2 = *(const GAS unsigned*)(pp + 2 * CD);
            x0 = (f32x2){bf_lo(r0), bf_hi(r0)}; x1 = (f32x2){bf_lo(r1), bf_hi(r1)}; x2 = (f32x2){bf_lo(r2), bf_hi(r2)}; }
        unsigned pkA[32], pkB[32];
        const bf16* src = XBC + (size_t)m0 * CD + c;
#pragma unroll
        for (int tb = 0; tb < 4; ++tb) { unsigned raw[16];
#pragma unroll
            for (int i = 0; i < 16; ++i) raw[i] = *(const GAS unsigned*)(src + (size_t)(tb * 16 + i) * CD);
#pragma unroll
            for (int i = 0; i < 16; i += 2) { const f32x2 xa = {bf_lo(raw[i]), bf_hi(raw[i])}, xb = {bf_lo(raw[i + 1]), bf_hi(raw[i + 1])};
                const f32x2 ta = bias + w0 * x0 + w1 * x1 + w2 * x2 + w3 * xa, tb2 = bias + w0 * x1 + w1 * x2 + w2 * xa + w3 * xb;
                x0 = x2; x1 = xa; x2 = xb;
                pkA[tb * 8 + (i >> 1)] = cvt_pk_bf16(silu_f(ta[0]), silu_f(tb2[0])); pkB[tb * 8 + (i >> 1)] = cvt_pk_bf16(silu_f(ta[1]), silu_f(tb2[1])); } }
        if (cb < 64) {
            u32x4* dst = (u32x4*)((bf16*)(a.ws + WS_XT) + ((size_t)(ch * 128 + 2 * cb + (lane >> 5)) * 64 + 2 * (lane & 31)) * 64);
#pragma unroll
            for (int i = 0; i < 8; ++i) { *(GAS u32x4*)(dst + i) = (u32x4){pkA[4 * i], pkA[4 * i + 1], pkA[4 * i + 2], pkA[4 * i + 3]}; *(GAS u32x4*)(dst + 8 + i) = (u32x4){pkB[4 * i], pkB[4 * i + 1], pkB[4 * i + 2], pkB[4 * i + 3]}; }
        } else {
            const int q = cb - 64, isC = q >= 8, g = q & 7, n = 2 * lane;
            unsigned* nat = (unsigned*)((bf16*)(a.ws + (isC ? WS_CN : WS_BN)) + (size_t)(ch * 8 + g) * 8192 + n);
#pragma unroll
            for (int i = 0; i < 32; ++i) { *(GAS unsigned*)(nat + (size_t)(2 * i) * 64) = (pkA[i] & 0xffffu) | (pkB[i] << 16); *(GAS unsigned*)(nat + (size_t)(2 * i + 1) * 64) = (pkA[i] >> 16) | (pkB[i] & 0xffff0000u); }
            if (!isC) { u32x4* dst = (u32x4*)((bf16*)(a.ws + WS_BT) + (size_t)(ch * 8 + g) * 8192 + (size_t)n * 64);
#pragma unroll
                for (int i = 0; i < 8; ++i) { *(GAS u32x4*)(dst + i) = (u32x4){pkA[4 * i], pkA[4 * i + 1], pkA[4 * i + 2], pkA[4 * i + 3]}; *(GAS u32x4*)(dst + 8 + i) = (u32x4){pkB[4 * i], pkB[4 * i + 1], pkB[4 * i + 2], pkB[4 * i + 3]}; } }
        }
    }
}

constexpr int L_BN = 0, L_CN = 17408, L_BT = 34816, L_XT = 53248, L_XT2 = 62464, L_G = 71680, L_SP = 80896, L_SC = 115712, L_Z = 117888, L_Y = 127104;
static_assert(L_Y + 9216 <= LDSCTL_OFF, "SSD LDS map");
#define MFMA32(a, b, c) __builtin_amdgcn_mfma_f32_32x32x16_bf16((a), (b), (c), 0, 0, 0)
__device__ __forceinline__ float dpp_add(float v, float x) { return v + x; }
__device__ __forceinline__ float wave_incl_scan(float v) {
#define DPPF(x, ctrl, rmask, bc) __builtin_bit_cast(float, __builtin_amdgcn_update_dpp(0, __builtin_bit_cast(int, (x)), (ctrl), (rmask), 0xf, (bc)))
    v += DPPF(v, 0x111, 0xf, true); v += DPPF(v, 0x112, 0xf, true); v += DPPF(v, 0x114, 0xf, true); v += DPPF(v, 0x118, 0xf, true);
    v += DPPF(v, 0x142, 0xa, false); v += DPPF(v, 0x143, 0xc, false);
#undef DPPF
    return v;
}
__device__ __forceinline__ void ssd_scan(LAS float* SC, float dtv, float a_h, int lane) {
    const float v = wave_incl_scan(dtv * a_h);
    const float tot = __builtin_bit_cast(float, __builtin_amdgcn_readlane(__builtin_bit_cast(int, v), 63));
    SC[lane] = v; SC[64 + lane] = dtv; SC[128 + lane] = dtv * __expf(tot - v); SC[192 + lane] = __expf(v); if (lane == 0) SC[256] = __expf(tot);
}
template <int PMODE> __device__ __forceinline__ void ssd_unit(const Args& a, LAS unsigned char* L, int tid, int ch0, int NC, int m0, int hd, const float* s_init, float* s_out, const bool pcs) {
    constexpr size_t SSTR = (size_t)128 * 8192;
    asm volatile("" : "+v"(tid));
    const int lane = tid & 63, wid = __builtin_amdgcn_readfirstlane(tid >> 6), r32 = lane & 31, hi = lane >> 5, g = hd >> 4;
    const float a_h = -expf(a.in[I_ALOG][hd]), dsk = a.in[I_DSKIP][hd];
    const unsigned char* gBN = a.ws + WS_BN; const unsigned char* gCN = a.ws + WS_CN; const unsigned char* gBT = a.ws + WS_BT; const unsigned char* gXT = a.ws + WS_XT;
    const float* DT = (const float*)(a.ws + WS_DT); const bf16* ZM = (const bf16*)(a.ws + WS_ZM); bf16* YM = (bf16*)(a.ws + (PMODE ? WS_XBC + 64 * MiB : WS_YM));
    u32x4 sBN[2], sCN[2], sBT[2], sXT, sZ; float dtn = 0.f;
#define SSD_ISSUE(ch) do { const size_t tg = (size_t)((ch) * 8 + g) * 16384; _Pragma("unroll") for (int i = 0; i < 2; ++i) { const size_t o = tg + (size_t)(tid + 512 * i) * 16; \
        sBN[i] = *(const GAS u32x4*)(gBN + o); sCN[i] = *(const GAS u32x4*)(gCN + o); sBT[i] = *(const GAS u32x4*)(gBT + o); } \
        sXT = *(const GAS u32x4*)(gXT + (size_t)((ch) * 128 + hd) * 8192 + (size_t)tid * 16); \
        sZ = *(const GAS u32x4*)(ZM + (size_t)(m0 + ((ch) - ch0) * 64 + (tid >> 3)) * DI + hd * 64 + (tid & 7) * 8); } while (0)
#define SSD_COMMIT() do { _Pragma("unroll") for (int i = 0; i < 2; ++i) { const int idx = tid + 512 * i; \
        *(LAS u32x4*)(L + L_BN + (idx >> 4) * 272 + (idx & 15) * 16) = sBN[i]; *(LAS u32x4*)(L + L_CN + (idx >> 4) * 272 + (idx & 15) * 16) = sCN[i]; \
        *(LAS u32x4*)(L + L_BT + (idx >> 3) * 144 + (idx & 7) * 16) = sBT[i]; } \
        *(LAS u32x4*)(L + L_XT + (tid >> 3) * 144 + (tid & 7) * 16) = sXT; *(LAS u32x4*)(L + L_Z + (tid >> 3) * 144 + (tid & 7) * 16) = sZ; } while (0)
    f32x16 st[2], sn[2];
    int sofs = r32 * 128 + ((wid - 4) & 3) * 32 + 4 * hi; asm volatile("" : "+v"(sofs));
#pragma unroll
    for (int r = 0; r < 16; ++r) { st[0][r] = 0.f; st[1][r] = 0.f; sn[0][r] = 0.f; sn[1][r] = 0.f; }
    LBAR();
    SSD_ISSUE(ch0);
    if (wid == 4) ssd_scan((LAS float*)(L + L_SC), *(const GAS float*)(DT + (size_t)(m0 + lane) * NH + hd), a_h, lane);
    if (wid >= 4) { const int nb = wid - 4;
        if (s_init) {
#pragma unroll
            for (int pb = 0; pb < 2; ++pb)
#pragma unroll
                for (int g4 = 0; g4 < 4; ++g4) { const f32x4 v = *(const GAS f32x4*)(s_init + sofs + pb * 4096 + 8 * g4);
                    st[pb][4 * g4] = v[0]; st[pb][4 * g4 + 1] = v[1]; st[pb][4 * g4 + 2] = v[2]; st[pb][4 * g4 + 3] = v[3]; }
        }
#pragma unroll
        for (int pb = 0; pb < 2; ++pb)
#pragma unroll
            for (int g4 = 0; g4 < 4; ++g4) { u32x2 w; w.x = cvt_pk_bf16(st[pb][4 * g4], st[pb][4 * g4 + 1]); w.y = cvt_pk_bf16(st[pb][4 * g4 + 2], st[pb][4 * g4 + 3]);
                *(LAS u32x2*)(L + L_SP + (pb * 32 + r32) * 272 + (nb * 32 + 8 * g4 + 4 * hi) * 2) = w; }
    }
    SSD_COMMIT();
    LBAR();
    int cur = 0;
    for (int c = 0; c < NC; ++c) {
        const int mc = m0 + c * 64; const bool has_next = c + 1 < NC;
        LAS float* SC = (LAS float*)(L + L_SC) + cur * 272;
        if (has_next && PMODE != 1) {
            if (pcs && wid >= 4) { const float* sp = s_init + (size_t)(c + 1) * SSTR;
#pragma unroll
                for (int pb = 0; pb < 2; ++pb)
#pragma unroll
                    for (int g4 = 0; g4 < 4; ++g4) { const f32x4 v = *(const GAS f32x4*)(sp + sofs + pb * 4096 + 8 * g4);
                        sn[pb][4 * g4] = v[0]; sn[pb][4 * g4 + 1] = v[1]; sn[pb][4 * g4 + 2] = v[2]; sn[pb][4 * g4 + 3] = v[3]; } }
            SSD_ISSUE(ch0 + c + 1); if (wid == 4) dtn = *(const GAS float*)(DT + (size_t)(mc + 64 + lane) * NH + hd); }
        if (wid < 4) {
            const int lb = wid >> 1, pb = wid & 1;
            if (wid != 1) { const int sb = wid & 1, l = lb * 32 + r32; f32x16 cb;
#pragma unroll
                for (int r = 0; r < 16; ++r) cb[r] = 0.f;
                LAS const unsigned char* pa = L + L_BN + (sb * 32 + r32) * 272 + hi * 16; LAS const unsigned char* pbb = L + L_CN + (lb * 32 + r32) * 272 + hi * 16;
#pragma unroll
                for (int kh = 0; kh < 2; ++kh) { bf16x8 fa[4], fb[4];
#pragma unroll
                    for (int k = 0; k < 4; ++k) { fa[k] = *(LAS const bf16x8*)(pa + (kh * 4 + k) * 32); fb[k] = *(LAS const bf16x8*)(pbb + (kh * 4 + k) * 32); }
                    __builtin_amdgcn_sched_barrier(0);
#pragma unroll
                    for (int k = 0; k < 4; ++k) cb = MFMA32(fa[k], fb[k], cb);
                    __builtin_amdgcn_sched_barrier(0); }
                const float al = SC[l];
#pragma unroll
                for (int g4 = 0; g4 < 4; ++g4) { const int s0 = sb * 32 + 8 * g4 + 4 * hi; const f32x4 as = *(LAS const f32x4*)(SC + s0), ds = *(LAS const f32x4*)(SC + 64 + s0); float gv[4];
#pragma unroll
                    for (int e = 0; e < 4; ++e) { const float t = cb[4 * g4 + e] * __expf(al - as[e]) * ds[e]; gv[e] = (s0 + e <= l) ? t : 0.f; }
                    u32x2 w; w.x = cvt_pk_bf16(gv[0], gv[1]); w.y = cvt_pk_bf16(gv[2], gv[3]); *(LAS u32x2*)(L + L_G + l * 144 + s0 * 2) = w; } }
        } else { const int t2 = tid - 256, p = t2 >> 2, seg = t2 & 3;
            LAS const unsigned char* src = L + L_XT + p * 144 + seg * 32; const u32x4 v0 = *(LAS const u32x4*)src, v1 = *(LAS const u32x4*)(src + 16);
            LAS const f32x4* wp = (LAS const f32x4*)(SC + 128 + seg * 16); const f32x4 wa = wp[0], wb = wp[1], wc4 = wp[2], wd = wp[3];
            u32x4 o0, o1;
            o0.x = cvt_pk_bf16(bf_lo(v0.x) * wa[0], bf_hi(v0.x) * wa[1]); o0.y = cvt_pk_bf16(bf_lo(v0.y) * wa[2], bf_hi(v0.y) * wa[3]); o0.z = cvt_pk_bf16(bf_lo(v0.z) * wb[0], bf_hi(v0.z) * wb[1]); o0.w = cvt_pk_bf16(bf_lo(v0.w) * wb[2], bf_hi(v0.w) * wb[3]);
            o1.x = cvt_pk_bf16(bf_lo(v1.x) * wc4[0], bf_hi(v1.x) * wc4[1]); o1.y = cvt_pk_bf16(bf_lo(v1.y) * wc4[2], bf_hi(v1.y) * wc4[3]); o1.z = cvt_pk_bf16(bf_lo(v1.z) * wd[0], bf_hi(v1.z) * wd[1]); o1.w = cvt_pk_bf16(bf_lo(v1.w) * wd[2], bf_hi(v1.w) * wd[3]);
            LAS unsigned char* dst = L + L_XT2 + p * 144 + seg * 32; *(LAS u32x4*)dst = o0; *(LAS u32x4*)(dst + 16) = o1; }
        LBAR();
        if (wid < 4) { const int lb = wid >> 1, pb = wid & 1; f32x16 y;
#pragma unroll
            for (int r = 0; r < 16; ++r) y[r] = 0.f;
            { LAS const unsigned char* pa = L + L_CN + (lb * 32 + r32) * 272 + hi * 16; LAS const unsigned char* pbb = L + L_SP + cur * 17408 + (pb * 32 + r32) * 272 + hi * 16;
#pragma unroll
              for (int kh = 0; kh < 2; ++kh) { bf16x8 fa[4], fb[4];
#pragma unroll
                  for (int k = 0; k < 4; ++k) { fa[k] = *(LAS const bf16x8*)(pa + (kh * 4 + k) * 32); fb[k] = *(LAS const bf16x8*)(pbb + (kh * 4 + k) * 32); }
                  __builtin_amdgcn_sched_barrier(0);
#pragma unroll
                  for (int k = 0; k < 4; ++k) y = MFMA32(fa[k], fb[k], y);
                  __builtin_amdgcn_sched_barrier(0); } }
            bf16x8 ga[4], xb[4];
            { LAS const unsigned char* pa = L + L_G + (lb * 32 + r32) * 144 + hi * 16; LAS const unsigned char* pbb = L + L_XT + (pb * 32 + r32) * 144 + hi * 16;
              ga[0] = *(LAS const bf16x8*)(pa); xb[0] = *(LAS const bf16x8*)(pbb); ga[1] = *(LAS const bf16x8*)(pa + 32); xb[1] = *(LAS const bf16x8*)(pbb + 32);
              if (lb) { ga[2] = *(LAS const bf16x8*)(pa + 64); xb[2] = *(LAS const bf16x8*)(pbb + 64); ga[3] = *(LAS const bf16x8*)(pa + 96); xb[3] = *(LAS const bf16x8*)(pbb + 96); } }
#pragma unroll
            for (int g4 = 0; g4 < 4; ++g4) { const f32x4 e4 = *(LAS const f32x4*)(SC + 192 + lb * 32 + 8 * g4 + 4 * hi); y[4 * g4] *= e4[0]; y[4 * g4 + 1] *= e4[1]; y[4 * g4 + 2] *= e4[2]; y[4 * g4 + 3] *= e4[3]; }
            y = MFMA32(ga[0], xb[0], y); y = MFMA32(ga[1], xb[1], y);
            if (lb) { y = MFMA32(ga[2], xb[2], y); y = MFMA32(ga[3], xb[3], y); }
            const int p = pb * 32 + r32;
#pragma unroll
            for (int g4 = 0; g4 < 4; ++g4) { const int l0 = lb * 32 + 8 * g4 + 4 * hi; const u32x2 xv = *(LAS const u32x2*)(L + L_XT + p * 144 + l0 * 2);
                const float xe[4] = {bf_lo(xv.x), bf_hi(xv.x), bf_lo(xv.y), bf_hi(xv.y)};
#pragma unroll
                for (int e = 0; e < 4; ++e) { const float zz = bf2f(*(LAS const bf16*)(L + L_Z + (l0 + e) * 144 + p * 2)); const float yv = (y[4 * g4 + e] + dsk * xe[e]) * zz; *(LAS bf16*)(L + L_Y + (l0 + e) * 144 + p * 2) = f2bf(yv); } }
        } else { const int nb = wid - 4; const float dA = SC[256];
#pragma unroll
            for (int r = 0; r < 16; ++r) { st[0][r] *= dA; st[1][r] *= dA; }
            LAS const unsigned char* pa = L + L_BT + (nb * 32 + r32) * 144 + hi * 16; bf16x8 af[4], x0f[4], x1f[4];
#pragma unroll
            for (int ks = 0; ks < 4; ++ks) { af[ks] = *(LAS const bf16x8*)(pa + ks * 32); x0f[ks] = *(LAS const bf16x8*)(L + L_XT2 + r32 * 144 + hi * 16 + ks * 32); x1f[ks] = *(LAS const bf16x8*)(L + L_XT2 + (32 + r32) * 144 + hi * 16 + ks * 32); }
            __builtin_amdgcn_sched_barrier(0);
#pragma unroll
            for (int ks = 0; ks < 4; ++ks) { st[0] = MFMA32(af[ks], x0f[ks], st[0]); st[1] = MFMA32(af[ks], x1f[ks], st[1]); }
            __builtin_amdgcn_sched_barrier(0);
            if (wid == 4 && has_next) ssd_scan((LAS float*)(L + L_SC) + (cur ^ 1) * 272, dtn, a_h, lane);
            if (pcs) { float* so = s_out + (size_t)c * SSTR;
#pragma unroll
                for (int pb = 0; pb < 2; ++pb)
#pragma unroll
                    for (int g4 = 0; g4 < 4; ++g4) *(GAS f32x4*)(so + sofs + pb * 4096 + 8 * g4) = (f32x4){st[pb][4 * g4], st[pb][4 * g4 + 1], st[pb][4 * g4 + 2], st[pb][4 * g4 + 3]};
                st[0] = sn[0]; st[1] = sn[1]; }
#pragma unroll
            for (int pb = 0; pb < 2; ++pb)
#pragma unroll
                for (int g4 = 0; g4 < 4; ++g4) { u32x2 w; w.x = cvt_pk_bf16(st[pb][4 * g4], st[pb][4 * g4 + 1]); w.y = cvt_pk_bf16(st[pb][4 * g4 + 2], st[pb][4 * g4 + 3]);
                    *(LAS u32x2*)(L + L_SP + (cur ^ 1) * 17408 + (pb * 32 + r32) * 272 + (nb * 32 + 8 * g4 + 4 * hi) * 2) = w; }
        }
        LBAR();
        *(GAS u32x4*)(YM + (size_t)(mc + (tid >> 3)) * DI + hd * 64 + (tid & 7) * 8) = *(LAS const u32x4*)(L + L_Y + (tid >> 3) * 144 + (tid & 7) * 16);
        if (has_next) { SSD_COMMIT(); }
        LBAR();
        cur ^= 1;
    }
    if (!pcs && wid >= 4) { const int nb = wid - 4;
#pragma unroll
        for (int pb = 0; pb < 2; ++pb)
#pragma unroll
            for (int g4 = 0; g4 < 4; ++g4) *(GAS f32x4*)(s_out + sofs + pb * 4096 + 8 * g4) = (f32x4){st[pb][4 * g4], st[pb][4 * g4 + 1], st[pb][4 * g4 + 2], st[pb][4 * g4 + 3]};
    }
#undef SSD_ISSUE
#undef SSD_COMMIT
}

constexpr int A_K = 0, A_V = 24576, A_WS = 73728, A_Q = 75776;
__device__ __forceinline__ void glds16(const void* gsrc, unsigned lds_dst) { unsigned keep;
    asm volatile("s_mov_b32 %0, m0\n\ts_mov_b32 m0, %2\n\ts_nop 0\n\tglobal_load_lds_dwordx4 %1, off\n\ts_mov_b32 m0, %0" : "=&s"(keep) : "v"(gsrc), "s"(lds_dst) : "memory"); }
__device__ __forceinline__ void glds16s(const void* sbase, unsigned voff, unsigned lds_dst) { unsigned keep;
    asm volatile("s_mov_b32 %0, m0\n\ts_mov_b32 m0, %3\n\ts_nop 0\n\tglobal_load_lds_dwordx4 %1, %2\n\ts_mov_b32 m0, %0" : "=&s"(keep) : "v"(voff), "s"(sbase), "s"(lds_dst) : "memory"); }
#define AWAIT_BAR(N) asm volatile("s_waitcnt vmcnt(" #N ") lgkmcnt(0)\n\ts_barrier" ::: "memory")
#define ABAR() asm volatile("s_waitcnt lgkmcnt(0)\n\ts_barrier" ::: "memory")
__device__ __forceinline__ float max3f(float a, float b, float c) { float r; asm("v_max3_f32 %0, %1, %2, %3" : "=v"(r) : "v"(a), "v"(b), "v"(c)); return r; }
__device__ __forceinline__ int crow(int r, int hi) { return (r & 3) + 8 * (r >> 2) + 4 * hi; }
template <int PMODE> __device__ __forceinline__ void attn_unit(const bf16* Kb, const bf16* Vb, int NT, const bf16* Qb, bf16* Ya, const bf16* Za, const float* anw, float* park, float lam, LAS unsigned char* shm, int tid,
                                                                     const bf16* Kbn, const bf16* Vbn, int NTn, const bf16* Qbn, bool pre, bf16x8 (&qx)[4]) {
    const int lane = tid & 63, r32 = lane & 31, hi = lane >> 5, wid = __builtin_amdgcn_readfirstlane(tid >> 6), rep = wid >> 1, th = wid & 1, half = wid >> 2;
    const unsigned lds0 = (unsigned)(uintptr_t)shm;
    LAS float* wsf = (LAS float*)(shm + A_WS) + wid * 64;
    const int vb0 = (int)(lds0 + A_V) + ((lane >> 4) & 1) * 32 + (lane & 3) * 8 + (4 * hi + ((lane & 15) >> 2)) * 64;
    for (int c = 0; c < 2; ++c) {
        const unsigned kvoff = (unsigned)(lane * 2048 + wid * 16 + c * 128);
        const unsigned vvoff = (unsigned)((16 * (wid & 3) + (lane >> 2)) * 2048 + (wid >> 2) * 64 + (lane & 3) * 16);
        const unsigned kdst = lds0 + A_K + wid * 1024, vdst0 = lds0 + A_V + wid * 1024, vdst1 = vdst0 + 8192;
#define ADMA_K(t, slot) glds16s((const char*)Kb + (size_t)(t) * 131072, kvoff, (unsigned)__builtin_amdgcn_readfirstlane(kdst + (slot) * 8192))
#define ADMA_V(t, slot) do { glds16s((const char*)Vb + (size_t)(t) * 131072, vvoff, (unsigned)__builtin_amdgcn_readfirstlane(vdst0 + (slot) * 16384)); glds16s((const char*)Vb + (size_t)(t) * 131072 + 128, vvoff, (unsigned)__builtin_amdgcn_readfirstlane(vdst1 + (slot) * 16384)); } while (0)
#define KLOAD(slot) do { LAS const unsigned char* kb_ = shm + A_K + (slot) * 8192 + hi * 1024 + r32 * 16; _Pragma("unroll") for (int d0 = 0; d0 < 4; ++d0) { kf[2 * d0] = *(LAS const bf16x8*)(kb_ + d0 * 2048); kf[2 * d0 + 1] = *(LAS const bf16x8*)(kb_ + d0 * 2048 + 512); } } while (0)
#define QLOAD() do { _Pragma("unroll") for (int d0 = 0; d0 < 4; ++d0) qr[d0] = *(LAS const bf16x8*)(qlds + d0 * 1024); } while (0)
#define QKT() do { p0 = MFMA32(kf[0], qr[0], zero16); p1 = MFMA32(kf[1], qr[0], zero16); _Pragma("unroll") for (int d0 = 1; d0 < 4; ++d0) { p0 = MFMA32(kf[2 * d0], qr[d0], p0); p1 = MFMA32(kf[2 * d0 + 1], qr[d0], p1); } } while (0)
        AWAIT_BAR(0);
        const bool have = (c == 0) && pre;
        if (!have) { ADMA_K(0, 0); ADMA_V(0, 0); if (NT > 1) { ADMA_K(1, 1); ADMA_V(1, 1); } if (NT > 2) ADMA_K(2, 2); }
        LAS unsigned char* qlds; { bf16x8 qr[4];
        if (have) {
#pragma unroll
            for (int d0 = 0; d0 < 4; ++d0) qr[d0] = qx[d0];
        } else {
#pragma unroll
            for (int d0 = 0; d0 < 4; ++d0) qr[d0] = *(const GAS bf16x8*)(Qb + (size_t)(32 * th + r32) * D + rep * 128 + c * 64 + d0 * 16 + hi * 8);
        }
        asm volatile("" : "+v"(qr[0]), "+v"(qr[1]), "+v"(qr[2]), "+v"(qr[3]));
        qlds = shm + A_Q + wid * 4096 + lane * 16;
#pragma unroll
        for (int d0 = 0; d0 < 4; ++d0) *(LAS bf16x8*)(qlds + d0 * 1024) = qr[d0]; }
        f32x16 o[4];
#pragma unroll
        for (int d = 0; d < 4; ++d)
#pragma unroll
            for (int r = 0; r < 16; ++r) o[d][r] = 0.f;
        float mref = 0.f, lsum = 0.f; int anyref = 0;
        f32x16 pA0, pA1, pB0, pB1;
        const f32x16 zero16 = {0.f, 0.f, 0.f, 0.f, 0.f, 0.f, 0.f, 0.f, 0.f, 0.f, 0.f, 0.f, 0.f, 0.f, 0.f, 0.f};
        int s0 = 0, s1 = 1, s2 = 2;
        AWAIT_BAR(0);
        { bf16x8 kf[8], qr[4]; KLOAD(0); QLOAD(); __builtin_amdgcn_sched_barrier(0);
          pA0 = MFMA32(kf[0], qr[0], zero16); pA1 = MFMA32(kf[1], qr[0], zero16);
#pragma unroll
          for (int d0 = 1; d0 < 4; ++d0) { pA0 = MFMA32(kf[2 * d0], qr[d0], pA0); pA1 = MFMA32(kf[2 * d0 + 1], qr[d0], pA1); } }
        if (half == 1) ABAR();
#define SM_GRP(g, PC0, PC1, PN0, PN1, WITH_QK, SUBM) do { \
            if (WITH_QK) { if ((g) + 2 < 8) { kf[((g) + 2) & 7] = *(LAS const bf16x8*)(kb_ + (((g) + 2) >> 1) * 2048 + (((g) + 2) & 1) * 512); if ((((g) + 2) & 1) == 0) qr[(((g) + 2) >> 1) & 3] = *(LAS const bf16x8*)(qlds + (((g) + 2) >> 1) * 1024); } \
                           if ((g) == 0) PN0 = MFMA32(kf[0], qr[0], zero16); else if ((g) == 1) PN1 = MFMA32(kf[1], qr[0], zero16); else if (((g) & 1) == 0) PN0 = MFMA32(kf[g], qr[(g) >> 1], PN0); else PN1 = MFMA32(kf[g], qr[(g) >> 1], PN1); } \
            if (SUBM) { PC0[2 * (g)] -= mref; PC0[2 * (g) + 1] -= mref; PC1[2 * (g)] -= mref; PC1[2 * (g) + 1] -= mref; } \
            PC0[2 * (g)] = __builtin_amdgcn_exp2f(PC0[2 * (g)]); PC0[2 * (g) + 1] = __builtin_amdgcn_exp2f(PC0[2 * (g) + 1]); PC1[2 * (g)] = __builtin_amdgcn_exp2f(PC1[2 * (g)]); PC1[2 * (g) + 1] = __builtin_amdgcn_exp2f(PC1[2 * (g) + 1]); \
            ps2 += (f32x2){PC0[2 * (g)], PC0[2 * (g) + 1]}; ps2 += (f32x2){PC1[2 * (g)], PC1[2 * (g) + 1]}; \
            pw[(g) >> 2][(g) & 3] = cvt_pk_bf16(PC0[2 * (g)], PC0[2 * (g) + 1]); pw[2 + ((g) >> 2)][(g) & 3] = cvt_pk_bf16(PC1[2 * (g)], PC1[2 * (g) + 1]); \
            __builtin_amdgcn_sched_barrier(0); } while (0)
#define SM_ALL(PC0, PC1, PN0, PN1, WITH_QK, SUBM) do { SM_GRP(0, PC0, PC1, PN0, PN1, WITH_QK, SUBM); SM_GRP(1, PC0, PC1, PN0, PN1, WITH_QK, SUBM); SM_GRP(2, PC0, PC1, PN0, PN1, WITH_QK, SUBM); SM_GRP(3, PC0, PC1, PN0, PN1, WITH_QK, SUBM); \
            SM_GRP(4, PC0, PC1, PN0, PN1, WITH_QK, SUBM); SM_GRP(5, PC0, PC1, PN0, PN1, WITH_QK, SUBM); SM_GRP(6, PC0, PC1, PN0, PN1, WITH_QK, SUBM); SM_GRP(7, PC0, PC1, PN0, PN1, WITH_QK, SUBM); } while (0)
#define ATT_STEP(t, PC0, PC1, PN0, PN1) do { \
              \
            if (!(PMODE & 1) && half == 1) { if ((t) + 3 < NT) ADMA_K((t) + 3, s0); if ((t) + 2 < NT) ADMA_V((t) + 2, s2); } \
            bf16x8 kf[8], qr[4]; LAS const unsigned char* kb_ = shm + A_K + s1 * 8192 + hi * 1024 + r32 * 16; \
            kf[0] = *(LAS const bf16x8*)(kb_); kf[1] = *(LAS const bf16x8*)(kb_ + 512); qr[0] = *(LAS const bf16x8*)(qlds);     \
            asm volatile("s_nop 15\n\ts_nop 7" : "+v"(PC0), "+v"(PC1));        \
            float rm = max3f(PC0[0], PC0[1], PC1[0]), rm2 = max3f(PC0[2], PC0[3], PC1[1]); rm = max3f(rm, PC1[2], PC1[3]); \
            _Pragma("unroll") for (int r = 4; r < 16; r += 4) { rm = max3f(rm, PC0[r], PC0[r + 1]); rm2 = max3f(rm2, PC0[r + 2], PC0[r + 3]); rm = max3f(rm, PC1[r], PC1[r + 1]); rm2 = max3f(rm2, PC1[r + 2], PC1[r + 3]); } \
            rm = max3f(rm, rm2, rm2); \
            { auto rr = __builtin_amdgcn_permlane32_swap(__float_as_uint(rm), __float_as_uint(rm), false, false); rm = fmaxf(__uint_as_float(rr[0]), __uint_as_float(rr[1])); } \
            { bool need_ = rm > mref + 16.f; if ((t) == 0) need_ = need_ || (rm < -16.f);     \
              if (__any(need_)) { \
                const float mnew = (t) == 0 ? (need_ ? rm : 0.f) : fmaxf(rm, mref), alpha = (t) == 0 ? 0.f : __builtin_amdgcn_exp2f(mref - mnew); \
                lsum *= alpha; mref = mnew; anyref = 1; \
                if (hi == 0) wsf[r32] = alpha; \
                asm volatile("s_waitcnt lgkmcnt(0)" ::: "memory"); \
                _Pragma("unroll") for (int g4 = 0; g4 < 4; ++g4) { const f32x4 f = *(LAS const f32x4*)(wsf + 8 * g4 + 4 * hi); \
                    _Pragma("unroll") for (int d = 0; d < 4; ++d) { o[d][4 * g4] *= f[0]; o[d][4 * g4 + 1] *= f[1]; o[d][4 * g4 + 2] *= f[2]; o[d][4 * g4 + 3] *= f[3]; } } \
              } } \
            f32x2 ps2 = {0.f, 0.f}; u32x4 pw[4]; \
            __builtin_amdgcn_sched_barrier(0); \
            if (__builtin_amdgcn_readfirstlane(anyref)) SM_ALL(PC0, PC1, PN0, PN1, true, true); else SM_ALL(PC0, PC1, PN0, PN1, true, false);     \
            const float ps = ps2[0] + ps2[1]; \
            lsum += ps; \
            bf16x8 pa[4]; pa[0] = __builtin_bit_cast(bf16x8, pw[0]); pa[1] = __builtin_bit_cast(bf16x8, pw[1]); pa[2] = __builtin_bit_cast(bf16x8, pw[2]); pa[3] = __builtin_bit_cast(bf16x8, pw[3]); \
            if (!(PMODE & 8)) { if (half == 0) ABAR(); else { if ((t) + 3 < NT) AWAIT_BAR(3); else AWAIT_BAR(0); } } \
              \
            if (!(PMODE & 1) && half == 0) { if ((t) + 3 < NT) ADMA_K((t) + 3, s0); if ((t) + 2 < NT) ADMA_V((t) + 2, s2); } \
            { const int vb = vb0 + s0 * 16384; typedef short s16x4 __attribute__((ext_vector_type(4))); s16x4 vlo[4], vhh[4];     \
              VRD1(0); VRD1(1); VRD1(2); VRD1(3); \
              VSTEP(0, 6); VSTEP(1, 6); VSTEP(2, 6); VSTEP(3, 6); VSTEP(4, 6); VSTEP(5, 6); VSTEP(6, 6); VSTEP(7, 6); VSTEP(8, 6); VSTEP(9, 6); VSTEP(10, 6); VSTEP(11, 6); VSTEP(12, 6); \
              VSTEP(13, 4); VSTEP(14, 2); VSTEP(15, 0); } \
            if (!(PMODE & 8)) { if (half == 0) { if ((t) + 3 < NT) AWAIT_BAR(3); else AWAIT_BAR(0); } else ABAR(); } \
            { const int tmp = s0; s0 = s1; s1 = s2; s2 = tmp; } } while (0)
#define VRD1(i) do { asm volatile("ds_read_b64_tr_b16 %0,%1 offset:%c2" : "=&v"(vlo[(i) & 3]) : "v"(vb), "i"(((i) >> 2) * 4096 + ((i) & 3) * 1024) : "memory"); \
                     asm volatile("ds_read_b64_tr_b16 %0,%1 offset:%c2" : "=&v"(vhh[(i) & 3]) : "v"(vb), "i"(((i) >> 2) * 4096 + ((i) & 3) * 1024 + 512) : "memory"); } while (0)
#define VSTEP(i, N) do { asm volatile("s_waitcnt lgkmcnt(" #N ")" : "+v"(vlo[(i) & 3]), "+v"(vhh[(i) & 3]) :: "memory"); \
            { const bf16x8 vf = (bf16x8){vlo[(i) & 3][0], vlo[(i) & 3][1], vlo[(i) & 3][2], vlo[(i) & 3][3], vhh[(i) & 3][0], vhh[(i) & 3][1], vhh[(i) & 3][2], vhh[(i) & 3][3]}; o[(i) >> 2] = MFMA32(pa[(i) & 3], vf, o[(i) >> 2]); } \
            if ((i) + 4 < 16) VRD1((i) + 4); } while (0)
        int t = 0;
        for (; t + 1 < NT; t += 2) { ATT_STEP(t, pA0, pA1, pB0, pB1); ATT_STEP(t + 1, pB0, pB1, pA0, pA1); }
        if (t < NT) ATT_STEP(t, pA0, pA1, pB0, pB1);
#undef VRD1
#undef VSTEP
#undef ATT_STEP
#undef SM_GRP
#undef SM_ALL
        if (half == 0) ABAR();
        { auto rr = __builtin_amdgcn_permlane32_swap(__float_as_uint(lsum), __float_as_uint(lsum), false, false); lsum = __uint_as_float(rr[0]) + __uint_as_float(rr[1]); }
        if (hi == 0) wsf[r32] = lsum;
        asm volatile("s_waitcnt lgkmcnt(0)" ::: "memory");
        float rli[16];
#pragma unroll
        for (int g4 = 0; g4 < 4; ++g4) { const f32x4 f = *(LAS const f32x4*)(wsf + 8 * g4 + 4 * hi); rli[4 * g4] = __builtin_amdgcn_rcpf(f[0]); rli[4 * g4 + 1] = __builtin_amdgcn_rcpf(f[1]); rli[4 * g4 + 2] = __builtin_amdgcn_rcpf(f[2]); rli[4 * g4 + 3] = __builtin_amdgcn_rcpf(f[3]); }
        const __amdgpu_buffer_rsrc_t prs = __builtin_amdgcn_make_buffer_rsrc((void*)park, 0, 32768 * 4, 0x00020000);
        unsigned toff = (unsigned)tid * 4u; asm volatile("" : "+v"(toff));
        if (c == 0) {
#pragma unroll
            for (int d = 0; d < 4; ++d)
#pragma unroll
                for (int r = 0; r < 16; ++r) __builtin_amdgcn_raw_buffer_store_b32(__float_as_uint(o[d][r] * rli[r]), prs, toff, (d * 16 + r) * 2048, 0);
        } else {
            const __amdgpu_buffer_rsrc_t yrs = __builtin_amdgcn_make_buffer_rsrc((void*)Ya, 0, 64 * D * 2, 0x00020000);
            const __amdgpu_buffer_rsrc_t zrs = __builtin_amdgcn_make_buffer_rsrc((void*)Za, 0, 64 * D * 2, 0x00020000);
            unsigned yoff = (unsigned)(((32 * th + 4 * hi) * D + rep * 128 + r32) * 2); asm volatile("" : "+v"(yoff));
            float ss[16];
#pragma unroll
            for (int r = 0; r < 16; ++r) ss[r] = 0.f;
#pragma unroll
            for (int dh = 0; dh < 2; ++dh) { float pv[2][16];
#pragma unroll
              for (int d = 0; d < 2; ++d)
#pragma unroll
                for (int r = 0; r < 16; ++r) pv[d][r] = __uint_as_float(__builtin_amdgcn_raw_buffer_load_b32(prs, toff, ((2 * dh + d) * 16 + r) * 2048, 0));
              __builtin_amdgcn_sched_barrier(0);
#pragma unroll
              for (int d = 0; d < 2; ++d)
#pragma unroll
                for (int r = 0; r < 16; ++r) { o[2 * dh + d][r] = pv[d][r] - lam * (o[2 * dh + d][r] * rli[r]); ss[r] += o[2 * dh + d][r] * o[2 * dh + d][r]; } }
            if (NTn > 0) {
                const unsigned kvn = (unsigned)(lane * 2048 + wid * 16);
                glds16s((const char*)Kbn, kvn, (unsigned)__builtin_amdgcn_readfirstlane(kdst)); glds16s((const char*)Vbn, vvoff, (unsigned)__builtin_amdgcn_readfirstlane(vdst0)); glds16s((const char*)Vbn + 128, vvoff, (unsigned)__builtin_amdgcn_readfirstlane(vdst1));
                if (NTn > 1) { glds16s((const char*)Kbn + 131072, kvn, (unsigned)__builtin_amdgcn_readfirstlane(kdst + 8192)); glds16s((const char*)Vbn + 131072, vvoff, (unsigned)__builtin_amdgcn_readfirstlane(vdst0 + 16384)); glds16s((const char*)Vbn + 131072 + 128, vvoff, (unsigned)__builtin_amdgcn_readfirstlane(vdst1 + 16384)); }
                if (NTn > 2) glds16s((const char*)Kbn + 2 * 131072, kvn, (unsigned)__builtin_amdgcn_readfirstlane(kdst + 2 * 8192));
#pragma unroll
                for (int d0 = 0; d0 < 4; ++d0) qx[d0] = *(const GAS bf16x8*)(Qbn + (size_t)(32 * th + r32) * D + rep * 128 + d0 * 16 + hi * 8);
            }
#pragma unroll
            for (int r = 0; r < 16; ++r) { float v = ss[r];
#define DPPA(x, ctrl) __builtin_bit_cast(float, __builtin_amdgcn_update_dpp(0, __builtin_bit_cast(int, (x)), (ctrl), 0xf, 0xf, true))
                v += DPPA(v, 0xB1); v += DPPA(v, 0x4E); v += DPPA(v, 0x141); v += DPPA(v, 0x140);
#undef DPPA
                v += __builtin_bit_cast(float, __builtin_amdgcn_ds_swizzle(__builtin_bit_cast(int, v), 0x401F));
                ss[r] = 0.8f * __builtin_amdgcn_rsqf(v * (1.f / 128.f) + EPS); }
            unsigned short zz[2][16];
#pragma unroll
            for (int d = 0; d < 4; ++d) { const float wn = anw[32 * d + r32];
                if ((d & 1) == 0) {
#pragma unroll
                    for (int dd = 0; dd < 2; ++dd)
#pragma unroll
                        for (int r = 0; r < 16; ++r) zz[dd][r] = (unsigned short)__builtin_amdgcn_raw_buffer_load_b16(zrs, yoff, (((r & 3) + 8 * (r >> 2)) * D + 32 * (d + dd)) * 2, 0);
                    __builtin_amdgcn_sched_barrier(0); }
#pragma unroll
                for (int r = 0; r < 16; ++r) { const float y = o[d][r] * ss[r] * wn * bf2f(zz[d & 1][r]);
                    __builtin_amdgcn_raw_buffer_store_b16((short)f2bf(y), yrs, yoff, (((r & 3) + 8 * (r >> 2)) * D + 32 * d) * 2, 0); } }
        }
#undef ADMA_K
#undef ADMA_V
#undef KLOAD
#undef QKT
#undef QLOAD
    }
}

__device__ __forceinline__ void phase_norm(const Args& a, int tid, int bx, int G, bool dummy = false) {
    const int lane = tid & 63, wave = tid >> 6, gw = bx * 8 + wave, NGW = G * 8;
    bf16* YM = (bf16*)(a.ws + WS_YM); bf16* YA = (bf16*)(a.ws + WS_YA); const bf16* ZA = (const bf16*)(a.ws + WS_ZA);
    for (int it = gw; it < M * 8; it += NGW) {
        const int g = it & 7; bf16* p = YM + (size_t)(it >> 3) * DI + g * 1024 + lane * 8;
        const u32x4 v0 = *(const GAS u32x4*)p, v1 = *(const GAS u32x4*)(p + 512);
        float x[16] = {bf_lo(v0.x), bf_hi(v0.x), bf_lo(v0.y), bf_hi(v0.y), bf_lo(v0.z), bf_hi(v0.z), bf_lo(v0.w), bf_hi(v0.w), bf_lo(v1.x), bf_hi(v1.x), bf_lo(v1.y), bf_hi(v1.y), bf_lo(v1.z), bf_hi(v1.z), bf_lo(v1.w), bf_hi(v1.w)};
        float s = 0.f;
#pragma unroll
        for (int i = 0; i < 16; ++i) s += x[i] * x[i];
        const float rstd = 1.f / sqrtf(wave_sum(s) * (1.f / 1024.f) + EPS);
        const float* nw = a.in[I_MNW] + g * 1024 + lane * 8;
        const f32x4 w0 = *(const GAS f32x4*)nw, w1 = *(const GAS f32x4*)(nw + 4), w2 = *(const GAS f32x4*)(nw + 512), w3 = *(const GAS f32x4*)(nw + 516);
        u32x4 o0, o1;
        o0.x = cvt_pk_bf16(x[0] * rstd * w0[0], x[1] * rstd * w0[1]); o0.y = cvt_pk_bf16(x[2] * rstd * w0[2], x[3] * rstd * w0[3]); o0.z = cvt_pk_bf16(x[4] * rstd * w1[0], x[5] * rstd * w1[1]); o0.w = cvt_pk_bf16(x[6] * rstd * w1[2], x[7] * rstd * w1[3]);
        o1.x = cvt_pk_bf16(x[8] * rstd * w2[0], x[9] * rstd * w2[1]); o1.y = cvt_pk_bf16(x[10] * rstd * w2[2], x[11] * rstd * w2[3]); o1.z = cvt_pk_bf16(x[12] * rstd * w3[0], x[13] * rstd * w3[1]); o1.w = cvt_pk_bf16(x[14] * rstd * w3[2], x[15] * rstd * w3[3]);
        bf16* pw = dummy ? p + (WS_XBC - WS_YM) / 2 : p; *(GAS u32x4*)pw = o0; *(GAS u32x4*)(pw + 512) = o1;
    }
}
__device__ __forceinline__ void phase_final(const Args& a, int tid, int bx, int G, bool dummy = false) {
    const int lane = tid & 63, wave = __builtin_amdgcn_readfirstlane(tid >> 6), gw = bx * 8 + wave, NGW = G * 8;
    f32x4 wv[16];
#pragma unroll
    for (int j = 0; j < 16; ++j) wv[j] = *(const GAS f32x4*)(a.in[I_FNW] + 4 * (64 * j + lane));
    const bool split = USE_SPLIT && G == 256;
#define FIN_LOAD(dst, row) do { const bool sp_ = split && (row) >= MP; const float* xr_ = (row) < MP ? a.in[I_XP] + (size_t)(row) * D : a.in[I_XS] + (size_t)((row) - MP) * D; \
        const float* ps_ = (const float*)(a.ws + WS_PS) + (size_t)((row) - MP) * D; const bf16* dl_ = (const bf16*)(a.ws + WS_DLT) + (size_t)(row) * D; \
        _Pragma("unroll") for (int j = 0; j < 16; ++j) { const int e = 4 * (64 * j + lane); \
            if (sp_) dst[j] = *(const GAS f32x4*)(xr_ + e) + ((*(const GAS f32x4*)(ps_ + e) + *(const GAS f32x4*)(ps_ + (size_t)MS * D + e)) + (*(const GAS f32x4*)(ps_ + (size_t)2 * MS * D + e) + *(const GAS f32x4*)(ps_ + (size_t)3 * MS * D + e))); \
            else { const u32x2 d2 = *(const GAS u32x2*)(dl_ + e); dst[j] = *(const GAS f32x4*)(xr_ + e) + (f32x4){bf_lo(d2.x), bf_hi(d2.x), bf_lo(d2.y), bf_hi(d2.y)}; } } } while (0)
    f32x4 v[16], nv[16];
    if (gw < M) FIN_LOAD(nv, gw);
    for (int row = gw; row < M; row += NGW) {
#pragma unroll
        for (int j = 0; j < 16; ++j) v[j] = nv[j];
        if (row + NGW < M) FIN_LOAD(nv, row + NGW);
        float s = 0.f;
#pragma unroll
        for (int j = 0; j < 16; ++j) s += (v[j][0] * v[j][0] + v[j][1] * v[j][1]) + (v[j][2] * v[j][2] + v[j][3] * v[j][3]);
        const float rstd = 1.f / sqrtf(wave_sum(s) * (1.f / D) + EPS);
        float* yo = dummy ? (float*)(a.ws + WS_XBC) + (size_t)row * D : a.out + O_Y + (size_t)row * D;
#pragma unroll
        for (int j = 0; j < 16; ++j) *(GAS f32x4*)(yo + 4 * (64 * j + lane)) = v[j] * rstd * wv[j];
    }
#undef FIN_LOAD
}

__global__ void __launch_bounds__(512, 2) mega_fwd(Args args) {
    extern __shared__ __attribute__((aligned(16))) unsigned char lds_raw[];
    LAS unsigned char* lds = (LAS unsigned char*)lds_raw;
    volatile LAS unsigned* MISC = (volatile LAS unsigned*)(lds + MISC_OFF);
    const int tid = threadIdx.x, bx = blockIdx.x, G = gridDim.x;
    for (int u = tid; u < (LDS_BYTES - LDSCTL_OFF) / 4; u += 512) ((LAS unsigned*)(lds + LDSCTL_OFF))[u] = 0u;
    __syncthreads();
    unsigned* ctl = (unsigned*)(args.ws + WS_CTL);
    XcdBarrier bar; bar.bar = ctl + CW_BAR; bar.x = 0; bar.st = nullptr;
    if (MK_N_LAUNCHES == 1) bar = xcd_barrier_post(ctl + CW_BAR, MISC + 8);
    const int lo = args.ph_lo, hi = args.ph_hi;
#ifdef ONLY_PHASE
#define IN(k) ((k) == ONLY_PHASE && lo <= (k) && (k) < hi)
#else
#define IN(k) (lo <= (k) && (k) < hi)
#endif
#define SEAM(k) do { if (IN(k) && IN((k) + 1)) xcd_barrier(bar); } while (0)

#define REPLOOP(N) for (int rep_ = 0; rep_ < (N); ++rep_, ((rep_ < (N)) ? xcd_barrier(bar) : (void)0))
    if (IN(0)) { REPLOOP(REP_P0) phase_prologue(args, lds, tid, bx, G, rep_ == 0); } SEAM(0);
#ifndef REP_P1
#define REP_P1 1
#endif
    if (IN(1)) { REPLOOP(REP_P1) phase_h(args, tid, bx, G, rep_ ? WS_ZM : WS_H); } SEAM(1);
    if (IN(2)) REPLOOP(REP_P2) {
        pg8::Gemm g{(const bf16*)(args.ws + WS_H), (const bf16*)(args.ws + WS_WIN), M, NIN, D}; pg8::StaticOrder S; S.init(M, NIN, G, bx);
        EpiIn E{args.ws, args.out, args.in[I_DTB]};
        pg8::gemm_phase<EpiIn, pg8::StaticOrder, true, true>(lds, g, S, E);
    } SEAM(2);
    if (IN(3)) { REPLOOP(REP_P3) phase_conv(args, tid, bx, G); } SEAM(3);
    if (IN(4)) {
        const int vcu = (G % 8 == 0) ? (bx % 8) * (G / 8) + bx / 8 : bx;
#ifndef NO_SSD
#ifndef SSD_HI
#define SSD_HI 16
#endif
        const bool ssd_bal = (G == 256); const int s_nc = vcu >= 128 ? SSD_HI : 16 - SSD_HI, s_b0 = vcu >= 128 ? 0 : SSD_HI;
        const int ssd_n = ssd_bal ? (s_nc > 0 ? 2 : 1) : (vcu < 2304 ? (2304 - vcu + G - 1) / G : 0);
        REPLOOP(REP_SSD) for (int ui = 0; ui < ssd_n; ++ui) { const int u = ssd_bal ? (ui == 0 ? vcu : 256 + s_b0 * 128 + (vcu & 127)) : vcu + G * ui; const int snc = ssd_bal ? s_nc : 1;
#ifdef PROBE_SSD_MODE
            if (rep_ > 0) { float* dummy = (float*)(args.ws + WS_XBC) + (size_t)u * 8192;
                if (u < 256) { const int b = u >> 7, hd = u & 127; ssd_unit<PROBE_SSD_MODE>(args, lds, tid, b * 128, 128, b * 8192, hd, nullptr, dummy, false); }
                else { const int us = u - 256, b = us >> 7, hd = us & 127; ssd_unit<PROBE_SSD_MODE>(args, lds, tid, 256 + b, 1, MP + b * 64, hd, args.in[I_SSSM] + (size_t)us * 8192, dummy, false); }
                continue; }
#endif
            if (u < 256) { const int b = u >> 7, hd = u & 127; ssd_unit<0>(args, lds, tid, b * 128, 128, b * 8192, hd, nullptr, args.out + O_SP + (size_t)u * 8192, false); }
            else { const int us = u - 256, b = us >> 7, hd = us & 127; ssd_unit<0>(args, lds, tid, 256 + b, snc, MP + b * 64, hd, args.in[I_SSSM] + (size_t)us * 8192, args.out + O_SS + (size_t)us * 8192, true); }
        }
#endif
        __syncthreads();
#ifndef NO_ATTN
        float lam;
        { float s1 = 0.f, s2 = 0.f; const int l = tid & 63; s1 = args.in[I_LQ1][l] * args.in[I_LK1][l]; s2 = args.in[I_LQ2][l] * args.in[I_LK2][l]; s1 = wave_sum(s1); s2 = wave_sum(s2); lam = expf(s1) - expf(s2) + 0.2f; lam = __builtin_bit_cast(float, __builtin_amdgcn_readfirstlane(__builtin_bit_cast(int, lam))); }
        int tid_a = threadIdx.x; asm volatile("" : "+v"(tid_a));
        const bf16* Qg = (const bf16*)(args.ws + WS_Q); bf16* Yag = (bf16*)(args.ws + WS_YA); float* park = (float*)(args.ws + WS_PARK) + (size_t)bx * 32768;
#define ATT_UP(it_, sub_, KB, VB, NT_, QR0, HKV) do { if ((it_) < 1024) { const int bh_ = (it_) >> 6, pr_ = (it_) & 63, b_ = bh_ >> 3, chunk_ = (sub_) ? 127 - pr_ : pr_; HKV = bh_ & 7; NT_ = chunk_ + 1; QR0 = b_ * 8192 + chunk_ * 64; \
            KB = (const bf16*)(args.ws + WS_KB) + (size_t)b_ * 8192 * 1024 + HKV * 128; VB = (const bf16*)(args.ws + WS_VB) + (size_t)b_ * 8192 * 1024 + HKV * 128; } \
        else { const int su_ = (it_) - 1024, b_ = su_ >> 3; HKV = su_ & 7; NT_ = 33; QR0 = MP + b_ * 64; KB = (const bf16*)(args.ws + WS_KS) + (size_t)b_ * 2112 * 1024 + HKV * 128; VB = (const bf16*)(args.ws + WS_VS) + (size_t)b_ * 2112 * 1024 + HKV * 128; } } while (0)
        REPLOOP(REP_ATT) { bf16x8 qx[4];
#pragma unroll
          for (int d0 = 0; d0 < 4; ++d0) qx[d0] = (bf16x8){0, 0, 0, 0, 0, 0, 0, 0};
          bool pre = false; int it = vcu, sub = 0;
          while (it < 1152) {
            const bf16 *Kb, *Vb, *Kbn = nullptr, *Vbn = nullptr; int NT, qrow0, hkv, NTn = 0, qrow0n = 0, hkvn = 0;
            ATT_UP(it, sub, Kb, Vb, NT, qrow0, hkv);
            int itn = it, subn = sub + 1; if (subn >= (it < 1024 ? 2 : 1)) { subn = 0; itn = it + G; }
            const bool hasn = itn < 1152;
            if (hasn) ATT_UP(itn, subn, Kbn, Vbn, NTn, qrow0n, hkvn);
            attn_unit<0>(Kb, Vb, NT, Qg + (size_t)qrow0 * D + hkv * 512, Yag + (size_t)qrow0 * D + hkv * 512, (const bf16*)(args.ws + WS_ZA) + (size_t)qrow0 * D + hkv * 512, args.in[I_ANW], park, lam, lds, tid_a,
                         Kbn, Vbn, hasn ? NTn : 0, Qg + (size_t)qrow0n * D + hkvn * 512, pre, qx);
            pre = hasn; it = itn; sub = subn;
          }
        }
#undef ATT_UP
#endif
        asm volatile("s_waitcnt vmcnt(0) lgkmcnt(0)" ::: "memory"); __syncthreads();
    } SEAM(4);
#ifndef REP_P5
#define REP_P5 1
#endif
    if (IN(5)) { REPLOOP(REP_P5) phase_norm(args, tid, bx, G, rep_ > 0); } SEAM(5);
    if (IN(6)) {
        pg8::Gemm2 g{(const bf16*)(args.ws + WS_YM), (const bf16*)(args.ws + WS_WPM), DI, (const bf16*)(args.ws + WS_YA), (const bf16*)(args.ws + WS_WPA), D}; pg8::SplitOrder S; S.init(G, bx);
        EpiG12 E{(const bf16*)(args.ws + WS_GM), (const bf16*)(args.ws + WS_GA), (bf16*)(args.ws + WS_MERGED), (float*)(args.ws + WS_TS)};
        pg8::gemm_phase2<EpiG12, pg8::SplitOrder>(lds, g, S, E);
    } SEAM(6);
    if (IN(7)) {
        if (USE_SPLIT && G == 256) { const float* TS = (const float*)(args.ws + WS_TS); bf16* MG = (bf16*)(args.ws + WS_MERGED) + (size_t)MP * D;
            for (int i = bx * 512 + tid; i < MS * D / 8; i += G * 512) { f32x4 t0 = {0.f, 0.f, 0.f, 0.f}, t1 = {0.f, 0.f, 0.f, 0.f};
#pragma unroll
                for (int sl = 0; sl < 4; ++sl) { t0 += *(const GAS f32x4*)(TS + (size_t)sl * MS * D + (size_t)i * 8); t1 += *(const GAS f32x4*)(TS + (size_t)sl * MS * D + (size_t)i * 8 + 4); }
                *(GAS u32x4*)(MG + (size_t)i * 8) = pack8(t0, t1); } }
    } SEAM(7);
    if (IN(8)) REPLOOP(REP_P7) {
        pg8::Gemm g{(const bf16*)(args.ws + WS_MERGED), (const bf16*)(args.ws + WS_WOUT), M, D, D}; pg8::SplitOrder S; S.init(G, bx);
        EpiOut E{(const float*)(args.ws + WS_MOD), (bf16*)(args.ws + WS_DLT), (float*)(args.ws + WS_PS)};
        pg8::gemm_phase<EpiOut, pg8::SplitOrder, true, true>(lds, g, S, E);
    } SEAM(8);
#ifndef REP_P9
#define REP_P9 1
#endif
    if (IN(9)) { for (int rep_ = REP_P9 - 1; rep_ >= 0; --rep_) { phase_final(args, tid, bx, G, rep_ > 0); if (rep_) xcd_barrier(bar); } }
#undef IN
#undef SEAM
}

extern "C" void kernel_launch(void* const* d_in, const int* in_sizes, int n_in, void* d_out, int out_size, void* d_ws, size_t ws_size, hipStream_t stream) {
    static int grid = 0;
    if (grid == 0) {
        if (n_in != 27 || out_size != 126382080 || ws_size < WS_END) { fprintf(stderr, "kernel_launch: unexpected problem: n_in %d out %d ws %zu (need %zu); nothing launched\n", n_in, out_size, ws_size, (size_t)WS_END); grid = -1; return; }
        int dev = 0, cus = 0, per_cu = 0;
        if (hipGetDevice(&dev) != hipSuccess || hipDeviceGetAttribute(&cus, hipDeviceAttributeMultiprocessorCount, dev) != hipSuccess) { grid = -1; return; }
        if (hipFuncSetAttribute((const void*)mega_fwd, hipFuncAttributeMaxDynamicSharedMemorySize, LDS_BYTES) != hipSuccess) { fprintf(stderr, "kernel_launch: hipFuncSetAttribute failed\n"); grid = -1; return; }
        if (hipOccupancyMaxActiveBlocksPerMultiprocessor(&per_cu, (const void*)mega_fwd, 512, LDS_BYTES) != hipSuccess || per_cu < 1) fprintf(stderr, "kernel_launch: occupancy query says %d\n", per_cu);
        (void)hipGetLastError();
        grid = cus;
    }
    if (grid < 0) return;
    if (hipMemsetAsync((char*)d_ws + WS_CTL, 0, CTL_ZERO_BYTES, stream) != hipSuccess) return;
    Args a{};
    for (int i = 0; i < 27; ++i) a.in[i] = (const float*)d_in[i];
    a.out = (float*)d_out; a.ws = (unsigned char*)d_ws;
    if (MK_N_LAUNCHES == 1) { a.ph_lo = 0; a.ph_hi = N_PHASES; hipLaunchKernelGGL(mega_fwd, dim3(grid), dim3(512), LDS_BYTES, stream, a); }
    else { for (int p = 0; p < N_PHASES; ++p) { a.ph_lo = p; a.ph_hi = p + 1; hipLaunchKernelGGL(mega_fwd, dim3(grid), dim3(512), LDS_BYTES, stream, a); } }
    const hipError_t le = hipPeekAtLastError();
    if (le != hipSuccess) fprintf(stderr, "kernel_launch: launch failed: %s\n", hipGetErrorName(le));
}
```

```cpp
#include <hip/hip_runtime.h>
#include <cstdio>
#include <cstdint>

#define GAS __attribute__((address_space(1)))
#define LAS __attribute__((address_space(3)))
typedef unsigned short bf16;
typedef short bf16x8 __attribute__((ext_vector_type(8)));
typedef float f32x4 __attribute__((ext_vector_type(4)));
typedef float f32x2 __attribute__((ext_vector_type(2)));
typedef float f32x16 __attribute__((ext_vector_type(16)));
typedef unsigned u32x4 __attribute__((ext_vector_type(4)));
typedef unsigned u32x2 __attribute__((ext_vector_type(2)));

#ifndef MK_N_LAUNCHES
#define MK_N_LAUNCHES 1
#endif
constexpr int N_PHASES = 10;
#ifndef USE_SPLIT
#define USE_SPLIT 1
#endif
#ifndef REP_P0
#define REP_P0 1
#endif
#ifndef REP_P2
#define REP_P2 1
#endif
#ifndef REP_P3
#define REP_P3 1
#endif
#ifndef REP_SSD
#define REP_SSD 1
#endif
#ifndef REP_ATT
#define REP_ATT 1
#endif
#ifndef REP_P6
#define REP_P6 1
#endif
#ifndef REP_P7
#define REP_P7 1
#endif

constexpr int D = 4096, MP = 16384, MS = 1024, M = MP + MS;
constexpr int NIN = 37120;
constexpr int DI = 8192, CD = 10240, NH = 128;
constexpr float EPS = 1e-6f;
constexpr float QSCALE = 0.125f * 1.4426950408889634f;

constexpr size_t O_Y = 0, O_KP = 71303168, O_VP = 88080384, O_CP = 104857600, O_SP = 104919040, O_KS = 107016192, O_VS = 108064768, O_CS = 109113344, O_SS = 109604864;

constexpr size_t MiB = 1u << 20;
constexpr size_t WS_CTL = 0, CTL_ZERO_BYTES = 2 * MiB;
constexpr size_t WS_MOD = 1 * MiB;
constexpr size_t WS_ROPE = 2 * MiB;
constexpr size_t WS_WPM = 4 * MiB, WS_WPA = 68 * MiB, WS_WOUT = 100 * MiB, WS_WIN = 132 * MiB;
constexpr size_t WS_YM = WS_WIN;
constexpr size_t WS_H = 422 * MiB;
constexpr size_t WS_YA = WS_H;
constexpr size_t WS_ZM = 558 * MiB;
constexpr size_t WS_MERGED = WS_ZM;
constexpr size_t WS_XBC = 830 * MiB;
constexpr size_t WS_PARK = WS_XBC;
constexpr size_t WS_T1 = WS_XBC;
constexpr size_t WS_Q = 1170 * MiB, WS_KB = 1306 * MiB, WS_VB = 1338 * MiB, WS_KS = 1370 * MiB, WS_VS = 1436 * MiB;
constexpr size_t WS_ZA = 1502 * MiB, WS_GM = 1638 * MiB, WS_GA = 1774 * MiB, WS_DT = 1910 * MiB;
constexpr size_t WS_XT = 1920 * MiB, WS_BN = 2192 * MiB, WS_BT = 2226 * MiB, WS_CN = 2260 * MiB, WS_END = 2294 * MiB;
constexpr size_t WS_TS = WS_Q;
constexpr size_t WS_DLT = WS_ZA;
constexpr size_t WS_PS = WS_KB;
constexpr int CW_BAR = 4096;

constexpr int RING_BYTES = 131072, LDS_BYTES = 147456, LDSCTL_OFF = LDS_BYTES - 512, MISC_OFF = LDSCTL_OFF + 320;

__device__ __forceinline__ unsigned cvt_pk_bf16(float lo, float hi) { unsigned r; asm volatile("v_cvt_pk_bf16_f32 %0, %1, %2" : "=v"(r) : "v"(lo), "v"(hi)); return r; }
__device__ __forceinline__ float bf_lo(unsigned u) { return __uint_as_float(u << 16); }
__device__ __forceinline__ float bf_hi(unsigned u) { return __uint_as_float(u & 0xffff0000u); }
__device__ __forceinline__ float bf2f(bf16 b) { return __uint_as_float((unsigned)b << 16); }
__device__ __forceinline__ bf16 f2bf(float f) { return (bf16)(cvt_pk_bf16(f, 0.f) & 0xffffu); }
__device__ __forceinline__ float silu_f(float x) { return x * __builtin_amdgcn_rcpf(1.f + __expf(-x)); }
__device__ __forceinline__ float sigm_f(float x) { return __builtin_amdgcn_rcpf(1.f + __expf(-x)); }
__device__ __forceinline__ float wave_sum(float v) {
#pragma unroll
    for (int o = 1; o < 64; o <<= 1) v += __shfl_xor(v, o);
    return v;
}
#define LBAR() do { asm volatile("s_waitcnt lgkmcnt(0)" ::: "memory"); __builtin_amdgcn_s_barrier(); asm volatile("" ::: "memory"); } while (0)

namespace pg8 {
#define PG8_LAS __attribute__((address_space(3)))
typedef unsigned short bf16_t;
constexpr int BM = 256, BK = 64, HALF = 128, HTB = HALF * BK * 2, STAGE_BYTES = 8 * HTB, NXCD = 8, WGM = 8;
__host__ __device__ __forceinline__ int lds_byte(int r, int c) { const int st = (r >> 4) * 2 + (c >> 5), rr = r & 15, cc = c & 31, ob = rr * 64 + cc * 2; return st * 1024 + (ob ^ (((ob >> 9) & 1) << 5)); }
__host__ __device__ __forceinline__ void stage_rc(int b, int& R, int& C) { const int st = b / 1024, sb = b % 1024, swz = sb ^ (((sb >> 9) & 1) << 5); R = (st >> 1) * 16 + swz / 64; C = (st & 1) * 32 + (swz % 64) / 2; }
__host__ __device__ __forceinline__ int perm32(int rho) { const int n = rho >> 4, i = rho & 15; return 8 * (i >> 2) + 4 * n + (i & 3); }
struct Unit { int pm, pn, kq, nq; };
struct Gemm { const bf16_t* A; const bf16_t* Bt; int M, N, K; };
struct StaticOrder {
    int nM, nN, nwg, G, c;
    __host__ __device__ void init(int M_, int N_, int G_, int c_) { nM = M_ / BM; nN = N_ / BM; nwg = nM * nN; G = G_; c = c_; }
    __host__ __device__ bool next(int i, Unit& u) const {
        const long L = (long)i * G + c; if (L >= nwg) return false;
        int wgid = (int)L; { const int q = nwg / NXCD, r = nwg % NXCD, xcd = wgid % NXCD, off = wgid / NXCD; wgid = (xcd < r ? xcd * (q + 1) : r * (q + 1) + (xcd - r) * q) + off; }
        const int nig = WGM * nN, gid = wgid / nig, fm = gid * WGM, gsz = (nM - fm) < WGM ? (nM - fm) : WGM;
        u.pm = fm + ((wgid % nig) % gsz); u.pn = (wgid % nig) / gsz; u.kq = 0; u.nq = 1; return true;
    }
    __device__ __forceinline__ void a_ready(const Unit&) const {}
    __device__ __forceinline__ void done(const Unit&) const {}
};
struct SplitOrder {
    StaticOrder sp, sf; bool split; int c;
    __host__ __device__ void init(int G_, int c_) { split = USE_SPLIT && (G_ == 256); c = c_; sp.init(16384, 4096, G_, c_); sf.init(17408, 4096, G_, c_); }
    __host__ __device__ bool next(int i, Unit& u) const {
        if (!split) return sf.next(i, u);
        if (i == 0) { const int su = c >> 2; u.pm = 64 + (su >> 4); u.pn = su & 15; u.kq = c & 3; u.nq = 4; return true; }
        return sp.next(i - 1, u);
    }
    __device__ __forceinline__ void a_ready(const Unit&) const {}
    __device__ __forceinline__ void done(const Unit&) const {}
};
template <class Epi, class Sched, bool ALIGN_EPI = false, bool SP2 = false>
__device__ __forceinline__ void gemm_phase(PG8_LAS unsigned char* lds, const Gemm g, const Sched& S, const Epi& E) {
    const int tid = threadIdx.x, wid = __builtin_amdgcn_readfirstlane(tid >> 6), lane = tid & 63, wr = wid >> 2, wc = wid & 3, fr = lane & 15, fq = lane >> 4;
    const int K = g.K, nt = K / BK;
    unsigned voffA[2], voffB[2];
#pragma unroll
    for (int i = 0; i < 2; ++i) { int R, C; stage_rc(tid * 16 + i * 8192, R, C); const int Rb = Epi::PERM ? ((R & ~31) + perm32(R & 31)) : R;
        voffA[i] = (unsigned)(R * K + C) * 2u; voffB[i] = (unsigned)(Rb * K + C) * 2u; }
    const size_t kstep = (size_t)(BK * 2);
    const size_t hstep = (size_t)HALF * K * 2;
    const size_t tstep = 2 * hstep;
    const unsigned ldsw = (unsigned)wid * 1024u;
    const int aoff = lds_byte(wr * 64 + fr, fq * 8), boff = lds_byte(wc * 32 + fr, fq * 8);
#define PG8_SA(b, h) (((b) * 2 + (h)) * HTB)
#define PG8_SB(b, h) ((4 + (b) * 2 + (h)) * HTB)
#define PG8_STAGE(bufoff, gbase, voff) do { _Pragma("unroll") for (int _i = 0; _i < 2; ++_i) \
        __builtin_amdgcn_global_load_lds((const unsigned*)((const char*)(gbase) + (voff)[_i]), (PG8_LAS unsigned*)(lds + (bufoff) + ldsw + _i * 8192), 16, 0, 0); } while (0)
#define PG8_LDA(dst, b, h) do { _Pragma("unroll") for (int m = 0; m < 4; ++m) _Pragma("unroll") for (int k = 0; k < 2; ++k) dst[m][k] = *(const PG8_LAS bf16x8*)(lds + PG8_SA(b, h) + aoff + m * 2048 + k * 1024); } while (0)
#define PG8_LDB(dst, b, h) do { _Pragma("unroll") for (int n = 0; n < 2; ++n) _Pragma("unroll") for (int k = 0; k < 2; ++k) dst[n][k] = *(const PG8_LAS bf16x8*)(lds + PG8_SB(b, h) + boff + n * 2048 + k * 1024); } while (0)
#define PG8_MMA(ai, bj, At, Bt) do { __builtin_amdgcn_s_setprio(1); _Pragma("unroll") for (int m = 0; m < 4; ++m) _Pragma("unroll") for (int n = 0; n < 2; ++n) _Pragma("unroll") for (int k = 0; k < 2; ++k) \
        acc[ai][bj][m][n] = __builtin_amdgcn_mfma_f32_16x16x32_bf16(Bt[n][k], At[m][k], acc[ai][bj][m][n], 0, 0, 0); __builtin_amdgcn_s_setprio(0); } while (0)
#define PG8_WAIT_V(n) asm volatile("s_waitcnt vmcnt(" #n ")" ::: "memory")
#define PG8_WAIT_L(n) asm volatile("s_waitcnt lgkmcnt(" #n ")" ::: "memory")
#define PG8_BAR __builtin_amdgcn_s_barrier()
#define PG8_SCHED __builtin_amdgcn_sched_barrier(0)
    Unit cur, nxt; int ui = 0;
    if (!S.next(0, cur)) return;
    f32x4 acc[2][2][4][2];
#pragma unroll
    for (int a = 0; a < 2; ++a)
#pragma unroll
        for (int b = 0; b < 2; ++b)
#pragma unroll
            for (int m = 0; m < 4; ++m)
#pragma unroll
                for (int n = 0; n < 2; ++n) acc[a][b][m][n] = (f32x4){0.f, 0.f, 0.f, 0.f};
    bf16x8 At[4][2], B0[2][2], B1[2][2];
    int ntc = nt / cur.nq;
    const char* cA = (const char*)g.A + (size_t)cur.pm * tstep + (size_t)(cur.kq * ntc) * kstep; const char* cB = (const char*)g.Bt + (size_t)cur.pn * tstep + (size_t)(cur.kq * ntc) * kstep;
    S.a_ready(cur);
    if constexpr (SP2) {
        PG8_STAGE(PG8_SB(0, 0), cB, voffB); PG8_STAGE(PG8_SB(0, 1), cB + hstep, voffB); PG8_STAGE(PG8_SA(0, 0), cA, voffA); PG8_STAGE(PG8_SA(0, 1), cA + hstep, voffA);
        if (wr == 1) PG8_BAR;
        PG8_WAIT_V(2); PG8_BAR;
        PG8_STAGE(PG8_SB(1, 0), cB + kstep, voffB); PG8_STAGE(PG8_SA(1, 0), cA + kstep, voffA); PG8_STAGE(PG8_SB(1, 1), cB + hstep + kstep, voffB);
        PG8_WAIT_V(6); PG8_BAR;
    } else {
        PG8_STAGE(PG8_SB(0, 0), cB, voffB); PG8_STAGE(PG8_SA(0, 0), cA, voffA); PG8_STAGE(PG8_SB(0, 1), cB + hstep, voffB); PG8_STAGE(PG8_SA(0, 1), cA + hstep, voffA);
        if (wr == 1) PG8_BAR;
        PG8_WAIT_V(4); PG8_BAR;
        PG8_STAGE(PG8_SB(1, 0), cB + kstep, voffB); PG8_STAGE(PG8_SA(1, 0), cA + kstep, voffA); PG8_STAGE(PG8_SB(1, 1), cB + hstep + kstep, voffB);
        PG8_WAIT_V(6); PG8_BAR;
    }
    for (;;) {
        const bool has_next = S.next(ui + 1, nxt);
        const int ntn = has_next ? nt / nxt.nq : ntc;
        const char* nA = has_next ? (const char*)g.A + (size_t)nxt.pm * tstep + (size_t)(nxt.kq * ntn) * kstep : cA; const char* nB = has_next ? (const char*)g.Bt + (size_t)nxt.pn * tstep + (size_t)(nxt.kq * ntn) * kstep : cB;
        for (int t = 0; t < ntc; t += 2) {
            const bool last = (t == ntc - 2);
            const char* a1 = cA + (size_t)(t + 1) * kstep;
            const char* a2 = last ? nA : cA + (size_t)(t + 2) * kstep; const char* b2 = last ? nB : cB + (size_t)(t + 2) * kstep;
            const char* a3 = a2 + kstep; const char* b3 = b2 + kstep;
            if (last && has_next) S.a_ready(nxt);
            if constexpr (SP2) {
            PG8_LDB(B0, 0, 0); PG8_LDB(B1, 0, 1); PG8_SCHED; PG8_LDA(At, 0, 0); PG8_STAGE(PG8_SA(1, 1), a1 + hstep, voffA);
            PG8_WAIT_V(8); PG8_WAIT_L(0); PG8_BAR; PG8_MMA(0, 0, At, B0); PG8_MMA(0, 1, At, B1); PG8_BAR; PG8_SCHED;
            PG8_LDA(At, 0, 1); PG8_STAGE(PG8_SB(0, 0), b2, voffB); PG8_STAGE(PG8_SB(0, 1), b2 + hstep, voffB); PG8_STAGE(PG8_SA(0, 0), a2, voffA);
            PG8_WAIT_V(8); PG8_WAIT_L(0); PG8_BAR; PG8_MMA(1, 0, At, B0); PG8_MMA(1, 1, At, B1); PG8_BAR; PG8_SCHED;
            PG8_LDB(B0, 1, 0); PG8_LDB(B1, 1, 1); PG8_SCHED; PG8_LDA(At, 1, 0); PG8_STAGE(PG8_SA(0, 1), a2 + hstep, voffA);
            PG8_WAIT_V(8); PG8_WAIT_L(0); PG8_BAR; PG8_MMA(0, 0, At, B0); PG8_MMA(0, 1, At, B1); PG8_BAR; PG8_SCHED;
            PG8_LDA(At, 1, 1); PG8_STAGE(PG8_SB(1, 0), b3, voffB); PG8_STAGE(PG8_SB(1, 1), b3 + hstep, voffB); PG8_STAGE(PG8_SA(1, 0), a3, voffA);
            PG8_WAIT_V(8); PG8_WAIT_L(0); PG8_BAR; PG8_MMA(1, 0, At, B0); PG8_MMA(1, 1, At, B1); PG8_BAR; PG8_SCHED;
            } else {
            PG8_LDB(B0, 0, 0); PG8_SCHED; PG8_LDA(At, 0, 0); PG8_STAGE(PG8_SA(1, 1), a1 + hstep, voffA);
            PG8_WAIT_L(8); PG8_BAR; PG8_WAIT_L(0); PG8_MMA(0, 0, At, B0); PG8_BAR; PG8_SCHED;
            PG8_LDB(B1, 0, 1); PG8_STAGE(PG8_SB(0, 0), b2, voffB);
            PG8_BAR; PG8_WAIT_L(0); PG8_MMA(0, 1, At, B1); PG8_BAR;
            PG8_LDA(At, 0, 1); PG8_STAGE(PG8_SA(0, 0), a2, voffA);
            PG8_BAR; PG8_WAIT_L(0); PG8_MMA(1, 0, At, B0); PG8_BAR; PG8_SCHED;
            PG8_STAGE(PG8_SB(0, 1), b2 + hstep, voffB);
            PG8_WAIT_V(6); PG8_BAR; PG8_MMA(1, 1, At, B1); PG8_BAR;
            PG8_LDB(B0, 1, 0); PG8_SCHED; PG8_LDA(At, 1, 0); PG8_STAGE(PG8_SA(0, 1), a2 + hstep, voffA);
            PG8_WAIT_L(8); PG8_BAR; PG8_WAIT_L(0); PG8_MMA(0, 0, At, B0); PG8_BAR; PG8_SCHED;
            PG8_LDB(B1, 1, 1); PG8_STAGE(PG8_SB(1, 0), b3, voffB);
            PG8_BAR; PG8_WAIT_L(0); PG8_MMA(0, 1, At, B1); PG8_BAR;
            PG8_LDA(At, 1, 1); PG8_STAGE(PG8_SA(1, 0), a3, voffA);
            PG8_BAR; PG8_WAIT_L(0); PG8_MMA(1, 0, At, B0); PG8_BAR; PG8_SCHED;
            PG8_STAGE(PG8_SB(1, 1), b3 + hstep, voffB);
            PG8_WAIT_V(6); PG8_BAR; PG8_MMA(1, 1, At, B1); PG8_BAR;
            }
        }
        if constexpr (ALIGN_EPI) { if (wr == 0) PG8_BAR; }
        E(acc, cur, wr, wc, fr, fq); S.done(cur);
        if (!has_next) break;
#pragma unroll
        for (int a = 0; a < 2; ++a)
#pragma unroll
            for (int b = 0; b < 2; ++b)
#pragma unroll
                for (int m = 0; m < 4; ++m)
#pragma unroll
                    for (int n = 0; n < 2; ++n) acc[a][b][m][n] = (f32x4){0.f, 0.f, 0.f, 0.f};
        cur = nxt; cA = nA; cB = nB; ntc = ntn; ++ui;
        if constexpr (ALIGN_EPI) { if (wr == 1) PG8_BAR; }
    }
    PG8_WAIT_V(0);
    if constexpr (!ALIGN_EPI) { if (wr == 0) PG8_BAR; }
    PG8_BAR;
#undef PG8_SA
#undef PG8_SB
#undef PG8_STAGE
#undef PG8_LDA
#undef PG8_LDB
#undef PG8_MMA
#undef PG8_WAIT_V
#undef PG8_WAIT_L
#undef PG8_BAR
#undef PG8_SCHED
}

struct Gemm2 { const bf16_t* A0; const bf16_t* B0; int K0; const bf16_t* A1; const bf16_t* B1; int K1; };
template <class Epi, class Sched>
__device__ __forceinline__ void gemm_phase2(PG8_LAS unsigned char* lds, const Gemm2 g, const Sched& S, const Epi& E) {
    const int tid = threadIdx.x, wid = __builtin_amdgcn_readfirstlane(tid >> 6), lane = tid & 63, wr = wid >> 2, wc = wid & 3, fr = lane & 15, fq = lane >> 4;
    unsigned r2A[2], r2B[2], c2[2];
#pragma unroll
    for (int i = 0; i < 2; ++i) { int R, C; stage_rc(tid * 16 + i * 8192, R, C); const int Rb = (R & ~31) + perm32(R & 31); r2A[i] = (unsigned)R * 2u; r2B[i] = (unsigned)Rb * 2u; c2[i] = (unsigned)C * 2u; }
    const size_t kstep = (size_t)(BK * 2);
    const unsigned ldsw = (unsigned)wid * 1024u;
    const int aoff = lds_byte(wr * 64 + fr, fq * 8), boff = lds_byte(wc * 32 + fr, fq * 8);
#define PG8_SA(b, h) (((b) * 2 + (h)) * HTB)
#define PG8_SB(b, h) ((4 + (b) * 2 + (h)) * HTB)
#define PG8_STAGE2(bufoff, gbase, v0, v1) do { \
        __builtin_amdgcn_global_load_lds((const unsigned*)((const char*)(gbase) + (v0)), (PG8_LAS unsigned*)(lds + (bufoff) + ldsw), 16, 0, 0); \
        __builtin_amdgcn_global_load_lds((const unsigned*)((const char*)(gbase) + (v1)), (PG8_LAS unsigned*)(lds + (bufoff) + ldsw + 8192), 16, 0, 0); } while (0)
#define PG8_LDA(dst, b, h) do { _Pragma("unroll") for (int m = 0; m < 4; ++m) _Pragma("unroll") for (int k = 0; k < 2; ++k) dst[m][k] = *(const PG8_LAS bf16x8*)(lds + PG8_SA(b, h) + aoff + m * 2048 + k * 1024); } while (0)
#define PG8_LDB(dst, b, h) do { _Pragma("unroll") for (int n = 0; n < 2; ++n) _Pragma("unroll") for (int k = 0; k < 2; ++k) dst[n][k] = *(const PG8_LAS bf16x8*)(lds + PG8_SB(b, h) + boff + n * 2048 + k * 1024); } while (0)
#define PG8_MMA(ai, bj, At, Bt) do { __builtin_amdgcn_s_setprio(1); _Pragma("unroll") for (int m = 0; m < 4; ++m) _Pragma("unroll") for (int n = 0; n < 2; ++n) _Pragma("unroll") for (int k = 0; k < 2; ++k) \
        acc[ai][bj][m][n] = __builtin_amdgcn_mfma_f32_16x16x32_bf16(Bt[n][k], At[m][k], acc[ai][bj][m][n], 0, 0, 0); __builtin_amdgcn_s_setprio(0); } while (0)
#define PG8_WAIT_V(n) asm volatile("s_waitcnt vmcnt(" #n ")" ::: "memory")
#define PG8_WAIT_L(n) asm volatile("s_waitcnt lgkmcnt(" #n ")" ::: "memory")
#define PG8_BAR __builtin_amdgcn_s_barrier()
#define PG8_SCHED __builtin_amdgcn_sched_barrier(0)
#define PG8_SEG(U, SEG, PA, PB, NT, HS, VA0, VA1, VB0, VB1) do { const int K_ = (SEG) ? g.K1 : g.K0; NT = (K_ / BK) / (U).nq; HS = (size_t)HALF * K_ * 2; \
        PA = (const char*)((SEG) ? g.A1 : g.A0) + (size_t)(U).pm * 2 * HS + (size_t)((U).kq * NT) * kstep; PB = (const char*)((SEG) ? g.B1 : g.B0) + (size_t)(U).pn * 2 * HS + (size_t)((U).kq * NT) * kstep; \
        VA0 = r2A[0] * (unsigned)K_ + c2[0]; VA1 = r2A[1] * (unsigned)K_ + c2[1]; VB0 = r2B[0] * (unsigned)K_ + c2[0]; VB1 = r2B[1] * (unsigned)K_ + c2[1]; } while (0)
    Unit cur, nxt; int ui = 0, cseg = 0;
    if (!S.next(0, cur)) return;
    f32x4 acc[2][2][4][2];
#pragma unroll
    for (int a = 0; a < 2; ++a)
#pragma unroll
        for (int b = 0; b < 2; ++b)
#pragma unroll
            for (int m = 0; m < 4; ++m)
#pragma unroll
                for (int n = 0; n < 2; ++n) acc[a][b][m][n] = (f32x4){0.f, 0.f, 0.f, 0.f};
    bf16x8 At[4][2], B0[2][2], B1[2][2];
    const char *cA, *cB, *nA, *nB; int ntc, ntn; size_t hsc, hsn; unsigned vAc0, vAc1, vBc0, vBc1, vAn0, vAn1, vBn0, vBn1;
    PG8_SEG(cur, 0, cA, cB, ntc, hsc, vAc0, vAc1, vBc0, vBc1);
    PG8_STAGE2(PG8_SB(0, 0), cB, vBc0, vBc1); PG8_STAGE2(PG8_SB(0, 1), cB + hsc, vBc0, vBc1); PG8_STAGE2(PG8_SA(0, 0), cA, vAc0, vAc1); PG8_STAGE2(PG8_SA(0, 1), cA + hsc, vAc0, vAc1);
    if (wr == 1) PG8_BAR;
    PG8_WAIT_V(2); PG8_BAR;
    PG8_STAGE2(PG8_SB(1, 0), cB + kstep, vBc0, vBc1); PG8_STAGE2(PG8_SA(1, 0), cA + kstep, vAc0, vAc1); PG8_STAGE2(PG8_SB(1, 1), cB + hsc + kstep, vBc0, vBc1);
    PG8_WAIT_V(6); PG8_BAR;
    for (;;) {
        bool has_next;
        if (cseg == 0) { has_next = true; nxt = cur; PG8_SEG(cur, 1, nA, nB, ntn, hsn, vAn0, vAn1, vBn0, vBn1); }
        else { has_next = S.next(ui + 1, nxt); if (has_next) PG8_SEG(nxt, 0, nA, nB, ntn, hsn, vAn0, vAn1, vBn0, vBn1); else { nA = cA; nB = cB; ntn = ntc; hsn = hsc; vAn0 = vAc0; vAn1 = vAc1; vBn0 = vBc0; vBn1 = vBc1; } }
        for (int t = 0; t < ntc; t += 2) {
            const bool last = (t == ntc - 2);
            const char* a1 = cA + (size_t)(t + 1) * kstep;
            const char* a2 = last ? nA : cA + (size_t)(t + 2) * kstep; const char* b2 = last ? nB : cB + (size_t)(t + 2) * kstep;
            const char* a3 = a2 + kstep; const char* b3 = b2 + kstep;
            const size_t h2 = last ? hsn : hsc; const unsigned wA0 = last ? vAn0 : vAc0, wA1 = last ? vAn1 : vAc1, wB0 = last ? vBn0 : vBc0, wB1 = last ? vBn1 : vBc1;
            PG8_LDB(B0, 0, 0); PG8_LDB(B1, 0, 1); PG8_SCHED; PG8_LDA(At, 0, 0); PG8_STAGE2(PG8_SA(1, 1), a1 + hsc, vAc0, vAc1);
            PG8_WAIT_V(8); PG8_WAIT_L(0); PG8_BAR; PG8_MMA(0, 0, At, B0); PG8_MMA(0, 1, At, B1); PG8_BAR; PG8_SCHED;
            PG8_LDA(At, 0, 1); PG8_STAGE2(PG8_SB(0, 0), b2, wB0, wB1); PG8_STAGE2(PG8_SB(0, 1), b2 + h2, wB0, wB1); PG8_STAGE2(PG8_SA(0, 0), a2, wA0, wA1);
            PG8_WAIT_V(8); PG8_WAIT_L(0); PG8_BAR; PG8_MMA(1, 0, At, B0); PG8_MMA(1, 1, At, B1); PG8_BAR; PG8_SCHED;
            PG8_LDB(B0, 1, 0); PG8_LDB(B1, 1, 1); PG8_SCHED; PG8_LDA(At, 1, 0); PG8_STAGE2(PG8_SA(0, 1), a2 + h2, wA0, wA1);
            PG8_WAIT_V(8); PG8_WAIT_L(0); PG8_BAR; PG8_MMA(0, 0, At, B0); PG8_MMA(0, 1, At, B1); PG8_BAR; PG8_SCHED;
            PG8_LDA(At, 1, 1); PG8_STAGE2(PG8_SB(1, 0), b3, wB0, wB1); PG8_STAGE2(PG8_SB(1, 1), b3 + h2, wB0, wB1); PG8_STAGE2(PG8_SA(1, 0), a3, wA0, wA1);
            PG8_WAIT_V(8); PG8_WAIT_L(0); PG8_BAR; PG8_MMA(1, 0, At, B0); PG8_MMA(1, 1, At, B1); PG8_BAR; PG8_SCHED;
        }
        if (wr == 0) PG8_BAR;
        if (cseg == 0) E.mid(acc, cur, wr, wc, fr, fq); else E(acc, cur, wr, wc, fr, fq);
        if (!has_next) break;
        if (cseg == 1) {
#pragma unroll
            for (int a = 0; a < 2; ++a)
#pragma unroll
                for (int b = 0; b < 2; ++b)
#pragma unroll
                    for (int m = 0; m < 4; ++m)
#pragma unroll
                        for (int n = 0; n < 2; ++n) acc[a][b][m][n] = (f32x4){0.f, 0.f, 0.f, 0.f};
            cur = nxt; ++ui; }
        cseg ^= 1; cA = nA; cB = nB; ntc = ntn; hsc = hsn; vAc0 = vAn0; vAc1 = vAn1; vBc0 = vBn0; vBc1 = vBn1;
        if (wr == 1) PG8_BAR;
    }
    PG8_WAIT_V(0);
    PG8_BAR;
#undef PG8_SA
#undef PG8_SB
#undef PG8_STAGE2
#undef PG8_LDA
#undef PG8_LDB
#undef PG8_MMA
#undef PG8_WAIT_V
#undef PG8_WAIT_L
#undef PG8_BAR
#undef PG8_SCHED
#undef PG8_SEG
}
}

#define EPI_FOR3 _Pragma("unroll") for (int ai = 0; ai < 2; ++ai) _Pragma("unroll") for (int m = 0; m < 4; ++m) _Pragma("unroll") for (int bj = 0; bj < 2; ++bj)

__device__ __forceinline__ u32x4 pack8(f32x4 v0, f32x4 v1) { u32x4 w; w.x = cvt_pk_bf16(v0[0], v0[1]); w.y = cvt_pk_bf16(v0[2], v0[3]); w.z = cvt_pk_bf16(v1[0], v1[1]); w.w = cvt_pk_bf16(v1[2], v1[3]); return w; }

struct EpiIn {
    static constexpr bool PERM = true, AFTER_DRAIN = false;
    unsigned char* ws; float* out; const float* dt_bias;
    template <int ACT> __device__ __forceinline__ void store_act(const f32x4 (&acc)[2][2][4][2], bf16* base, int ld, int rbase, int col0) const {
        EPI_FOR3 { f32x4 v0 = acc[ai][bj][m][0], v1 = acc[ai][bj][m][1];
            if (ACT == 1) { _Pragma("unroll") for (int e = 0; e < 4; ++e) { v0[e] = silu_f(v0[e]); v1[e] = silu_f(v1[e]); } }
            if (ACT == 2) { _Pragma("unroll") for (int e = 0; e < 4; ++e) { v0[e] = sigm_f(v0[e]); v1[e] = sigm_f(v1[e]); } }
            *(GAS u32x4*)(base + (size_t)(rbase + ai * 128 + m * 16) * ld + col0 + bj * 128) = pack8(v0, v1); }
    }
    __device__ __forceinline__ void operator()(const f32x4 (&acc)[2][2][4][2], const pg8::Unit& u, int wr, int wc, int fr, int fq) const {
        const int pn = u.pn, rbase = u.pm * 256 + wr * 64 + fr, cl = wc * 32 + 8 * fq;
        if (pn < 32) { store_act<1>(acc, (bf16*)(ws + WS_ZM), DI, rbase, pn * 256 + cl); }
        else if (pn < 72) {
            const int c0 = (pn - 32) * 256 + cl;
            store_act<0>(acc, (bf16*)(ws + WS_XBC), CD, rbase, c0);
            if (fr >= 13 && (u.pm >= 64 || ((u.pm & 31) == 31 && wr == 1))) {
#pragma unroll
                for (int ai = 0; ai < 2; ++ai) { if (u.pm < 64 && ai == 0) continue;
                    const int row = rbase + ai * 128 + 48; float* dst;
                    if (row < MP) dst = out + O_CP + (size_t)((row >> 13) * 3 + ((row & 8191) - 8189)) * CD; else dst = out + O_CS + (size_t)(((row - MP) >> 6) * 3 + ((row & 63) - 61)) * CD;
#pragma unroll
                    for (int bj = 0; bj < 2; ++bj) { *(GAS f32x4*)(dst + c0 + bj * 128) = acc[ai][bj][3][0]; *(GAS f32x4*)(dst + c0 + bj * 128 + 4) = acc[ai][bj][3][1]; } }
            }
        }
        else if (pn < 96) {
            const int kind = pn < 88 ? 0 : (pn < 92 ? 1 : 2);
            const int c0 = (pn - (kind == 0 ? 72 : (kind == 1 ? 88 : 92))) * 256 + cl;
            const float* rope = (const float*)(ws + WS_ROPE);
            EPI_FOR3 { f32x4 v0 = acc[ai][bj][m][0], v1 = acc[ai][bj][m][1];
                const int row = rbase + ai * 128 + m * 16;
                if (kind < 2 && (wc & 1) == 0) {
                    f32x4 p0, p1;
#pragma unroll
                    for (int e = 0; e < 4; ++e) { p0[e] = __shfl_xor(v0[e], 16); p1[e] = __shfl_xor(v1[e], 16); }
                    if (fq < 2) {
                        const int pos = row < MP ? (row & 8191) : 2048 + (row & 63);
                        const f32x4 c0v = *(const GAS f32x4*)(rope + pos * 16), c1v = *(const GAS f32x4*)(rope + pos * 16 + 4), s0v = *(const GAS f32x4*)(rope + pos * 16 + 8), s1v = *(const GAS f32x4*)(rope + pos * 16 + 12);
                        const float sg = fq == 0 ? -1.f : 1.f;
                        v0 = v0 * c0v + sg * (p0 * s0v); v1 = v1 * c1v + sg * (p1 * s1v);
                    }
                }
                if (kind == 0) { v0 = v0 * QSCALE; v1 = v1 * QSCALE; *(GAS u32x4*)((bf16*)(ws + WS_Q) + (size_t)row * D + c0 + bj * 128) = pack8(v0, v1); }
                else {
                    float* fo; bf16* bo;
                    if (row < MP) { fo = out + (kind == 1 ? O_KP : O_VP) + (size_t)row * 1024; bo = (bf16*)(ws + (kind == 1 ? WS_KB : WS_VB)) + (size_t)row * 1024; }
                    else { const int rs = row - MP; fo = out + (kind == 1 ? O_KS : O_VS) + (size_t)rs * 1024; bo = (bf16*)(ws + (kind == 1 ? WS_KS : WS_VS)) + (size_t)((rs >> 6) * 2112 + 2048 + (rs & 63)) * 1024; }
                    *(GAS f32x4*)(fo + c0 + bj * 128) = v0; *(GAS f32x4*)(fo + c0 + bj * 128 + 4) = v1;
                    *(GAS u32x4*)(bo + c0 + bj * 128) = pack8(v0, v1);
                }
            }
        }
        else if (pn < 112) { store_act<1>(acc, (bf16*)(ws + WS_ZA), D, rbase, (pn - 96) * 256 + cl); }
        else if (pn < 128) { store_act<2>(acc, (bf16*)(ws + WS_GM), D, rbase, (pn - 112) * 256 + cl); }
        else if (pn < 144) { store_act<2>(acc, (bf16*)(ws + WS_GA), D, rbase, (pn - 128) * 256 + cl); }
        else {
            float* DT = (float*)(ws + WS_DT);
            const f32x4 b0 = *(const GAS f32x4*)(dt_bias + cl), b1 = *(const GAS f32x4*)(dt_bias + cl + 4);
#pragma unroll
            for (int ai = 0; ai < 2; ++ai)
#pragma unroll
                for (int m = 0; m < 4; ++m) { f32x4 v0 = acc[ai][0][m][0] + b0, v1 = acc[ai][0][m][1] + b1;
#pragma unroll
                    for (int e = 0; e < 4; ++e) { v0[e] = v0[e] > 20.f ? v0[e] : log1pf(expf(v0[e])); v1[e] = v1[e] > 20.f ? v1[e] : log1pf(expf(v1[e])); }
                    float* dst = DT + (size_t)(rbase + ai * 128 + m * 16) * NH + cl; *(GAS f32x4*)dst = v0; *(GAS f32x4*)(dst + 4) = v1; }
        }
    }
};
__device__ __forceinline__ void atomic_add8(float* p, f32x4 v0, f32x4 v1) {
#pragma unroll
    for (int e = 0; e < 4; ++e) { unsafeAtomicAdd(p + e, v0[e]); unsafeAtomicAdd(p + 4 + e, v1[e]); }
}
struct EpiG1 {
    static constexpr bool PERM = true, AFTER_DRAIN = false;
    const bf16* GM; float* T1; float* TS;
    __device__ __forceinline__ void operator()(const f32x4 (&acc)[2][2][4][2], const pg8::Unit& u, int wr, int wc, int fr, int fq) const {
        const int rbase = u.pm * 256 + wr * 64 + fr, c0 = u.pn * 256 + wc * 32 + 8 * fq;
        u32x4 gv[2][4][2];
        EPI_FOR3 gv[ai][m][bj] = *(const GAS u32x4*)(GM + (size_t)(rbase + ai * 128 + m * 16) * D + c0 + bj * 128);
        float* dst = (u.nq > 1) ? TS + (size_t)u.kq * MS * D - (size_t)MP * D : T1;
        EPI_FOR3 { const size_t off = (size_t)(rbase + ai * 128 + m * 16) * D + c0 + bj * 128; const u32x4 g = gv[ai][m][bj];
            f32x4 v0 = acc[ai][bj][m][0], v1 = acc[ai][bj][m][1];
            v0[0] *= bf_lo(g.x); v0[1] *= bf_hi(g.x); v0[2] *= bf_lo(g.y); v0[3] *= bf_hi(g.y); v1[0] *= bf_lo(g.z); v1[1] *= bf_hi(g.z); v1[2] *= bf_lo(g.w); v1[3] *= bf_hi(g.w);
            *(GAS f32x4*)(dst + off) = v0; *(GAS f32x4*)(dst + off + 4) = v1; }
    }
};
struct EpiG2 {
    static constexpr bool PERM = true, AFTER_DRAIN = false;
    const bf16* GA; const float* T1; bf16* MG; float* TS;
    __device__ __forceinline__ void operator()(const f32x4 (&acc)[2][2][4][2], const pg8::Unit& u, int wr, int wc, int fr, int fq) const {
        const int rbase = u.pm * 256 + wr * 64 + fr, c0 = u.pn * 256 + wc * 32 + 8 * fq;
        const bool sp = u.nq > 1; float* ts = TS + (size_t)(4 + u.kq) * MS * D - (size_t)MP * D;
#pragma unroll
        for (int am = 0; am < 4; ++am) { const int ai = am >> 1, mh = (am & 1) * 2; u32x4 gv[4][2]; f32x4 t0[4][2], t1[4][2];
#pragma unroll
            for (int m = mh; m < mh + 2; ++m)
#pragma unroll
                for (int bj = 0; bj < 2; ++bj) { const size_t off = (size_t)(rbase + ai * 128 + m * 16) * D + c0 + bj * 128; gv[m][bj] = *(const GAS u32x4*)(GA + off);
                    if (!sp) { t0[m][bj] = *(const GAS f32x4*)(T1 + off); t1[m][bj] = *(const GAS f32x4*)(T1 + off + 4); } else { t0[m][bj] = (f32x4){0.f, 0.f, 0.f, 0.f}; t1[m][bj] = (f32x4){0.f, 0.f, 0.f, 0.f}; } }
#pragma unroll
            for (int m = mh; m < mh + 2; ++m)
#pragma unroll
                for (int bj = 0; bj < 2; ++bj) { const size_t off = (size_t)(rbase + ai * 128 + m * 16) * D + c0 + bj * 128; const u32x4 g = gv[m][bj];
                    f32x4 v0 = acc[ai][bj][m][0], v1 = acc[ai][bj][m][1];
                    v0[0] = t0[m][bj][0] + v0[0] * bf_lo(g.x); v0[1] = t0[m][bj][1] + v0[1] * bf_hi(g.x); v0[2] = t0[m][bj][2] + v0[2] * bf_lo(g.y); v0[3] = t0[m][bj][3] + v0[3] * bf_hi(g.y);
                    v1[0] = t1[m][bj][0] + v1[0] * bf_lo(g.z); v1[1] = t1[m][bj][1] + v1[1] * bf_hi(g.z); v1[2] = t1[m][bj][2] + v1[2] * bf_lo(g.w); v1[3] = t1[m][bj][3] + v1[3] * bf_hi(g.w);
                    if (sp) { *(GAS f32x4*)(ts + off) = v0; *(GAS f32x4*)(ts + off + 4) = v1; } else *(GAS u32x4*)(MG + off) = pack8(v0, v1); } }
    }
};
struct EpiG12 {
    static constexpr bool PERM = true, AFTER_DRAIN = false;
    const bf16* GM; const bf16* GA; bf16* MG; float* TS;
    __device__ __forceinline__ void mid(f32x4 (&acc)[2][2][4][2], const pg8::Unit& u, int wr, int wc, int fr, int fq) const {
        asm volatile("" : "+v"(fr), "+v"(fq));
        const int rbase = u.pm * 256 + wr * 64 + fr, c0 = u.pn * 256 + wc * 32 + 8 * fq;
#pragma unroll
        for (int ai = 0; ai < 2; ++ai) { u32x4 gm[4][2], ga[4][2];
#pragma unroll
            for (int m = 0; m < 4; ++m)
#pragma unroll
                for (int bj = 0; bj < 2; ++bj) { const size_t off = (size_t)(rbase + ai * 128 + m * 16) * D + c0 + bj * 128; gm[m][bj] = *(const GAS u32x4*)(GM + off); ga[m][bj] = *(const GAS u32x4*)(GA + off); }
#pragma unroll
            for (int m = 0; m < 4; ++m)
#pragma unroll
                for (int bj = 0; bj < 2; ++bj) { const u32x4 a = gm[m][bj], b = ga[m][bj];
#define RAT(x, y) ((x) * __builtin_amdgcn_rcpf(fmaxf((y), 1e-20f)))
                    acc[ai][bj][m][0][0] *= RAT(bf_lo(a.x), bf_lo(b.x)); acc[ai][bj][m][0][1] *= RAT(bf_hi(a.x), bf_hi(b.x)); acc[ai][bj][m][0][2] *= RAT(bf_lo(a.y), bf_lo(b.y)); acc[ai][bj][m][0][3] *= RAT(bf_hi(a.y), bf_hi(b.y));
                    acc[ai][bj][m][1][0] *= RAT(bf_lo(a.z), bf_lo(b.z)); acc[ai][bj][m][1][1] *= RAT(bf_hi(a.z), bf_hi(b.z)); acc[ai][bj][m][1][2] *= RAT(bf_lo(a.w), bf_lo(b.w)); acc[ai][bj][m][1][3] *= RAT(bf_hi(a.w), bf_hi(b.w));
#undef RAT
                } }
    }
    __device__ __forceinline__ void operator()(const f32x4 (&acc)[2][2][4][2], const pg8::Unit& u, int wr, int wc, int fr, int fq) const {
        asm volatile("" : "+v"(fr), "+v"(fq));
        const int rbase = u.pm * 256 + wr * 64 + fr, c0 = u.pn * 256 + wc * 32 + 8 * fq;
        const bool sp = u.nq > 1; float* ts = TS + (size_t)u.kq * MS * D - (size_t)MP * D;
        u32x4 gv[2][4][2];
        EPI_FOR3 gv[ai][m][bj] = *(const GAS u32x4*)(GA + (size_t)(rbase + ai * 128 + m * 16) * D + c0 + bj * 128);
        EPI_FOR3 { const size_t off = (size_t)(rbase + ai * 128 + m * 16) * D + c0 + bj * 128; const u32x4 g = gv[ai][m][bj];
            f32x4 v0 = acc[ai][bj][m][0], v1 = acc[ai][bj][m][1];
            v0[0] *= bf_lo(g.x); v0[1] *= bf_hi(g.x); v0[2] *= bf_lo(g.y); v0[3] *= bf_hi(g.y); v1[0] *= bf_lo(g.z); v1[1] *= bf_hi(g.z); v1[2] *= bf_lo(g.w); v1[3] *= bf_hi(g.w);
            if (sp) { *(GAS f32x4*)(ts + off) = v0; *(GAS f32x4*)(ts + off + 4) = v1; } else *(GAS u32x4*)(MG + off) = pack8(v0, v1); }
    }
};
struct EpiOut {
    static constexpr bool PERM = true, AFTER_DRAIN = false;
    const float* mod; bf16* DLT; float* PS;
    __device__ __forceinline__ void operator()(const f32x4 (&acc)[2][2][4][2], const pg8::Unit& u, int wr, int wc, int fr, int fq) const {
        const int rbase = u.pm * 256 + wr * 64 + fr, c0 = u.pn * 256 + wc * 32 + 8 * fq; const bool sp = u.nq > 1;
#pragma unroll
        for (int ai = 0; ai < 2; ++ai) { const int row0 = rbase + ai * 128; const int bi = row0 < MP ? (row0 >> 13) : 2 + ((row0 - MP) >> 6);
            const float* gp = mod + (size_t)bi * 12288 + 8192 + c0;
            f32x4 g0[2], g1[2];
#pragma unroll
            for (int bj = 0; bj < 2; ++bj) { g0[bj] = *(const GAS f32x4*)(gp + bj * 128); g1[bj] = *(const GAS f32x4*)(gp + bj * 128 + 4); }
            float* yb = PS + (size_t)u.kq * MS * D + (size_t)(row0 - MP) * D; bf16* xb = DLT + (size_t)row0 * D;
#pragma unroll
            for (int m = 0; m < 4; ++m)
#pragma unroll
                for (int bj = 0; bj < 2; ++bj) { const size_t o_ = (size_t)(m * 16) * D + c0 + bj * 128; const f32x4 r0 = g0[bj] * acc[ai][bj][m][0], r1 = g1[bj] * acc[ai][bj][m][1];
                    if (sp) { *(GAS f32x4*)(yb + o_) = r0; *(GAS f32x4*)(yb + o_ + 4) = r1; } else *(GAS u32x4*)(xb + o_) = pack8(r0, r1); } }
    }
};

#define XB_TMO      128
#define XB_XCNT(j)  (256  + 64 * (j))
#define XB_XSUB(j)  (1280 + 64 * (j))
#define XB_XGEN(j)  (2304 + 64 * (j))
#define XB_TOP      3328
#define XB_TOPGEN   3392
#define XCD_BAR_WORDS 3456
#define XB_SPIN_CAP (1u << 18)
__device__ __forceinline__ unsigned xb_ld(unsigned* p)              { return __hip_atomic_load(p, __ATOMIC_RELAXED, __HIP_MEMORY_SCOPE_AGENT); }
__device__ __forceinline__ unsigned xb_add(unsigned* p, unsigned v) { return __hip_atomic_fetch_add(p, v, __ATOMIC_RELAXED, __HIP_MEMORY_SCOPE_AGENT); }
__device__ __forceinline__ unsigned xb_xcc_id() { return (unsigned)__builtin_amdgcn_s_getreg((3 << 11) | 20) & 0xFu; }
#define XB_SPIN(cond, bar) do { unsigned _sp = 0; while (cond) { __builtin_amdgcn_s_sleep(1); \
    if ((++_sp & 255u) == 0u) { if (xb_ld(&(bar)[XB_TMO])) break; if (_sp > XB_SPIN_CAP) { atomicAdd(&(bar)[XB_TMO], 1u); break; } } } } while (0)
struct XcdBarrier { unsigned* bar; unsigned x; volatile LAS unsigned* st; };
__device__ __forceinline__ XcdBarrier xcd_barrier_post(unsigned* bar, volatile LAS unsigned* st) {
    XcdBarrier b; b.bar = bar; b.x = xb_xcc_id(); b.st = st;
    if (threadIdx.x == 0) (void)xb_add(&bar[XB_XCNT(b.x)], 1u);
    return b;
}
__device__ __forceinline__ void xcd_barrier_complete(unsigned* bar, unsigned x, unsigned& nloc, unsigned& nx) {
    const unsigned G = gridDim.x * gridDim.y * gridDim.z;
    unsigned sum, cnt, mine, sp = 0u;
    for (;;) {
        sum = 0u; cnt = 0u; mine = 0u;
#pragma unroll
        for (unsigned j = 0; j < 16; ++j) { const unsigned c = xb_ld(&bar[XB_XCNT(j)]); sum += c; cnt += (c > 0u) ? 1u : 0u; mine = (j == x) ? c : mine; }
        if (sum == G) break;
        __builtin_amdgcn_s_sleep(1);
        if ((++sp & 255u) == 0u) { if (xb_ld(&bar[XB_TMO])) break; if (sp > XB_SPIN_CAP) { atomicAdd(&bar[XB_TMO], 1u); break; } }
    }
    nloc = mine > 0u ? mine : 1u; nx = cnt > 0u ? cnt : 1u;
}
__device__ __forceinline__ void xcd_barrier(const XcdBarrier& b) {
    asm volatile("s_waitcnt vmcnt(0)" ::: "memory");
    __syncthreads();
    if (threadIdx.x == 0) {
        unsigned* bar = b.bar;
        __builtin_amdgcn_s_waitcnt(0);
        unsigned nloc = b.st[0], nx = b.st[1];
        if (nloc == 0u) { xcd_barrier_complete(bar, b.x, nloc, nx); b.st[0] = nloc; b.st[1] = nx; }
        const unsigned old = xb_add(&bar[XB_XSUB(b.x)], 1u);
        const unsigned gen = old / nloc;
        if (old + 1u == (gen + 1u) * nloc) {
            __builtin_amdgcn_fence(__ATOMIC_RELEASE, "agent");
            asm volatile("s_waitcnt vmcnt(0)" ::: "memory");
            const unsigned og = xb_add(&bar[XB_TOP], 1u);
            const unsigned tg = og / nx;
            if (og + 1u == (tg + 1u) * nx) xb_add(&bar[XB_TOPGEN], 1u);
            else XB_SPIN(xb_ld(&bar[XB_TOPGEN]) == tg, bar);
            __builtin_amdgcn_fence(__ATOMIC_ACQUIRE, "agent");
            xb_add(&bar[XB_XGEN(b.x)], 1u);
            asm volatile("s_waitcnt vmcnt(0)" ::: "memory");
        } else {
            XB_SPIN(xb_ld(&bar[XB_XGEN(b.x)]) == gen, bar);
            __builtin_amdgcn_fence(__ATOMIC_ACQUIRE, "agent");
            asm volatile("s_waitcnt vmcnt(0)" ::: "memory");
        }
    }
    __syncthreads();
}

struct Args { const float* in[27]; float* out; unsigned char* ws; int ph_lo, ph_hi; };
enum { I_XP = 0, I_XS, I_CK, I_CV, I_SCONV, I_SSSM, I_CP, I_CS, I_WADA, I_BADA, I_NORMW, I_WIN, I_CONVW, I_CONVB, I_DTB, I_ALOG, I_DSKIP, I_MNW, I_LQ1, I_LK1, I_LQ2, I_LK2, I_ANW, I_WPM, I_WPA, I_WOUT, I_FNW };

__device__ __forceinline__ void p0_transpose_item(const float* W, int K, int N, bf16* WT, int row_off, LAS float* scr, int kb, int nb, int lane) {
    const int k0 = 64 * kb, n0 = 32 * nb;
#pragma unroll 8
    for (int i = 0; i < 32; ++i) { const int kk = 2 * i + (lane >> 5); scr[kk * 33 + (lane & 31)] = *(const GAS float*)(W + (size_t)(k0 + kk) * N + n0 + (lane & 31)); }
    asm volatile("s_waitcnt lgkmcnt(0)" ::: "memory");
    const int c = lane & 7;
#pragma unroll
    for (int j = 0; j < 4; ++j) { const int n = (lane >> 3) + 8 * j; const LAS float* s = scr + (8 * c) * 33 + n;
        u32x4 o; o.x = cvt_pk_bf16(s[0 * 33], s[1 * 33]); o.y = cvt_pk_bf16(s[2 * 33], s[3 * 33]); o.z = cvt_pk_bf16(s[4 * 33], s[5 * 33]); o.w = cvt_pk_bf16(s[6 * 33], s[7 * 33]);
        *(GAS u32x4*)(WT + (size_t)(row_off + n0 + n) * K + k0 + 8 * c) = o; }
    asm volatile("s_waitcnt lgkmcnt(0)" ::: "memory");
}
__device__ __forceinline__ void p0_transpose_tile(const float* W, int K, int N, bf16* WT, int row_off, int kb, int nb, int lane) {
    const int k0 = 64 * kb + 16 * (lane >> 4), n0 = 64 * nb + 4 * (lane & 15);
    f32x4 v[16];
    const float* src = W + (size_t)k0 * N + n0;
#pragma unroll
    for (int i = 0; i < 16; ++i) v[i] = __builtin_nontemporal_load((const GAS f32x4*)(src + (size_t)i * N));
    bf16* dst = WT + (size_t)(row_off + n0) * K + k0;
#pragma unroll
    for (int e = 0; e < 4; ++e)
#pragma unroll
        for (int h = 0; h < 2; ++h) { u32x4 o; o.x = cvt_pk_bf16(v[8 * h][e], v[8 * h + 1][e]); o.y = cvt_pk_bf16(v[8 * h + 2][e], v[8 * h + 3][e]); o.z = cvt_pk_bf16(v[8 * h + 4][e], v[8 * h + 5][e]); o.w = cvt_pk_bf16(v[8 * h + 6][e], v[8 * h + 7][e]);
            *(GAS u32x4*)(dst + (size_t)e * K + 8 * h) = o; }
}
__device__ __forceinline__ void phase_prologue(const Args& a, LAS unsigned char* lds, int tid, int bx, int G, bool do_mod = true) {
    const int lane = tid & 63, wave = __builtin_amdgcn_readfirstlane(tid >> 6);
    const int gw = bx * 8 + wave, NGW = G * 8, gt = bx * 512 + tid, NGT = G * 512;
    if (do_mod) for (int task = bx; task < 96; task += G) {
        const int ks = task / 6, cg = task % 6, k0 = ks * 256;
        LAS float* sc = (LAS float*)lds;
        for (int i = tid; i < 18 * 256; i += 512) { const int b = i >> 8, k = i & 255; const float c = (b < 2) ? a.in[I_CP][b * D + k0 + k] : a.in[I_CS][(b - 2) * D + k0 + k]; sc[k * 20 + b] = silu_f(c); }
        __syncthreads();
        const int col = cg * 2048 + wave * 256 + lane * 4;
        f32x4 acc[18];
#pragma unroll
        for (int b = 0; b < 18; ++b) acc[b] = (f32x4){0.f, 0.f, 0.f, 0.f};
        const float* wp = a.in[I_WADA] + (size_t)k0 * 12288 + col;
#pragma unroll 8
        for (int k = 0; k < 256; ++k) { const f32x4 w = __builtin_nontemporal_load((const GAS f32x4*)(wp + (size_t)k * 12288));
            const LAS f32x4* s4 = (const LAS f32x4*)(sc + k * 20);
            const f32x4 s0 = s4[0], s1 = s4[1], s2 = s4[2], s3 = s4[3], s4v = s4[4];
            acc[0] += s0[0] * w; acc[1] += s0[1] * w; acc[2] += s0[2] * w; acc[3] += s0[3] * w; acc[4] += s1[0] * w; acc[5] += s1[1] * w; acc[6] += s1[2] * w; acc[7] += s1[3] * w;
            acc[8] += s2[0] * w; acc[9] += s2[1] * w; acc[10] += s2[2] * w; acc[11] += s2[3] * w; acc[12] += s3[0] * w; acc[13] += s3[1] * w; acc[14] += s3[2] * w; acc[15] += s3[3] * w;
            acc[16] += s4v[0] * w; acc[17] += s4v[1] * w; }
        float* mod = (float*)(a.ws + WS_MOD);
        f32x4 bias = (f32x4){0.f, 0.f, 0.f, 0.f}; if (ks == 0) bias = *(const GAS f32x4*)(a.in[I_BADA] + col);
#pragma unroll
        for (int b = 0; b < 18; ++b)
#pragma unroll
            for (int e = 0; e < 4; ++e) unsafeAtomicAdd(mod + (size_t)b * 12288 + col + e, acc[b][e] + bias[e]);
        __syncthreads();
    }
    { float* rope = (float*)(a.ws + WS_ROPE);
      const float invf[8] = {1.0f, 0.1939227432012558f, 0.03760603070259094f, 0.007292664609849453f, 0.0014142135623842478f, 0.00027424818836152554f, 5.3182957344688475e-05f, 1.0313385246263351e-05f};
      for (int i = gt; i < 8192 * 8; i += NGT) { const int pos = i >> 3, k = i & 7; float inv = invf[0];
#pragma unroll
          for (int q = 1; q < 8; ++q) inv = (k == q) ? invf[q] : inv;
          const float ang = (float)pos * inv; const double ad = (double)ang; const double nrev = __builtin_rint(ad * 0.15915494309189535); const float r = (float)(ad - nrev * 6.283185307179586);
          rope[pos * 16 + k] = __cosf(r); rope[pos * 16 + 8 + k] = __sinf(r); } }
    { constexpr int NB_IN = 36992 / 64, I_IN = 64 * NB_IN, I_PM = 128 * 64, I_PA = 64 * 64, I_OUT = 64 * 64, NIT = I_IN + I_PM + I_PA + I_OUT;
      for (int it = gw; it < NIT; it += NGW) { int r = it;
          if (r < I_IN) { const int kb = r / NB_IN, nb = r % NB_IN, n0 = nb * 64; const int off = n0 < 18432 ? 0 : (n0 < 18560 ? 36864 - 18432 : -128);
              p0_transpose_tile(a.in[I_WIN], D, 36992, (bf16*)(a.ws + WS_WIN), off, kb, nb, lane); continue; } r -= I_IN;
          if (r < I_PM) { p0_transpose_tile(a.in[I_WPM], DI, D, (bf16*)(a.ws + WS_WPM), 0, r / 64, r % 64, lane); continue; } r -= I_PM;
          if (r < I_PA) { p0_transpose_tile(a.in[I_WPA], D, D, (bf16*)(a.ws + WS_WPA), 0, r / 64, r % 64, lane); continue; } r -= I_PA;
          p0_transpose_tile(a.in[I_WOUT], D, D, (bf16*)(a.ws + WS_WOUT), 0, r / 64, r % 64, lane); }
      u32x4* padp = (u32x4*)((bf16*)(a.ws + WS_WIN) + (size_t)36992 * D);
      for (int i = gt; i < 128 * D / 8; i += NGT) *(GAS u32x4*)(padp + i) = (u32x4){0u, 0u, 0u, 0u}; }
    for (int i = gt; i < 2 * 4194304; i += NGT) { const int which = i >= 4194304, j = which ? i - 4194304 : i; const size_t src = (size_t)j * 8; const int b = j >> 18;
        const float* sp = a.in[which ? I_CV : I_CK] + src; const f32x4 v0 = *(const GAS f32x4*)sp, v1 = *(const GAS f32x4*)(sp + 4);
        *(GAS u32x4*)((bf16*)(a.ws + (which ? WS_VS : WS_KS)) + src + (size_t)b * 65536) = pack8(v0, v1); }
}
__device__ __forceinline__ void phase_h(const Args& a, int tid, int bx, int G, size_t hoff = WS_H) {
    const int lane = tid & 63, wave = tid >> 6, gw = bx * 8 + wave, NGW = G * 8;
    const float* mod = (const float*)(a.ws + WS_MOD); bf16* H = (bf16*)(a.ws + hoff);
    constexpr int NPAIR = M / 2; const int nfull = (NPAIR / NGW) * NGW, nrem = NPAIR - nfull;
    const int rstep = nrem > 0 ? NGW / nrem : 1;
    for (int i = 0;; ++i) {
        int rp;
        if ((i + 1) * NGW <= nfull) rp = i * NGW + gw;
        else { if (nrem == 0 || gw % rstep != 0 || gw / rstep >= nrem) break; rp = nfull + gw / rstep; }
        const int row = 2 * rp;
        const float* xr = row < MP ? a.in[I_XP] + (size_t)row * D : a.in[I_XS] + (size_t)(row - MP) * D; const int bi = row < MP ? (row >> 13) : 2 + ((row - MP) >> 6);
        f32x4 v[2][8][2]; float s0 = 0.f, s1 = 0.f;
#pragma unroll
        for (int q = 0; q < 2; ++q)
#pragma unroll
            for (int j = 0; j < 8; ++j) { v[q][j][0] = *(const GAS f32x4*)(xr + q * D + 8 * (64 * j + lane)); v[q][j][1] = *(const GAS f32x4*)(xr + q * D + 8 * (64 * j + lane) + 4); }
#pragma unroll
        for (int j = 0; j < 8; ++j) {
            s0 += (v[0][j][0][0] * v[0][j][0][0] + v[0][j][0][1] * v[0][j][0][1]) + (v[0][j][0][2] * v[0][j][0][2] + v[0][j][0][3] * v[0][j][0][3]) + (v[0][j][1][0] * v[0][j][1][0] + v[0][j][1][1] * v[0][j][1][1]) + (v[0][j][1][2] * v[0][j][1][2] + v[0][j][1][3] * v[0][j][1][3]);
            s1 += (v[1][j][0][0] * v[1][j][0][0] + v[1][j][0][1] * v[1][j][0][1]) + (v[1][j][0][2] * v[1][j][0][2] + v[1][j][0][3] * v[1][j][0][3]) + (v[1][j][1][0] * v[1][j][1][0] + v[1][j][1][1] * v[1][j][1][1]) + (v[1][j][1][2] * v[1][j][1][2] + v[1][j][1][3] * v[1][j][1][3]); }
        const float rstd0 = 1.f / sqrtf(wave_sum(s0) * (1.f / D) + EPS), rstd1 = 1.f / sqrtf(wave_sum(s1) * (1.f / D) + EPS);
        const float* sh = mod + (size_t)bi * 12288; const float* scl = sh + 4096; const float* nw = a.in[I_NORMW];
#pragma unroll
        for (int j = 0; j < 8; ++j) { const int c = 8 * (64 * j + lane);
#pragma unroll
            for (int h = 0; h < 2; ++h) { const f32x4 w = *(const GAS f32x4*)(nw + c + 4 * h), sc = *(const GAS f32x4*)(scl + c + 4 * h), sf = *(const GAS f32x4*)(sh + c + 4 * h);
                const f32x4 m = w * (1.f + sc);
                v[0][j][h] = v[0][j][h] * rstd0 * m + sf; v[1][j][h] = v[1][j][h] * rstd1 * m + sf; }
            *(GAS u32x4*)(H + (size_t)row * D + c) = pack8(v[0][j][0], v[0][j][1]); *(GAS u32x4*)(H + (size_t)(row + 1) * D + c) = pack8(v[1][j][0], v[1][j][1]); }
        if ((i + 1) * NGW > nfull) break;
    }
}
__device__ __forceinline__ void phase_conv(const Args& a, int tid, int bx, int G) {
    const int lane = tid & 63, wave = tid >> 6, gw = bx * 8 + wave, NGW = G * 8;
    const bf16* XBC = (const bf16*)(a.ws + WS_XBC);
    for (int u = gw; u < 272 * 80; u += NGW) {
        const int ch = u / 80, cb = u % 80, c = cb * 128 + 2 * lane, m0 = ch * 64;
        const f32x2 w0 = *(const GAS f32x2*)(a.in[I_CONVW] + c), w1 = *(const GAS f32x2*)(a.in[I_CONVW] + CD + c), w2 = *(const GAS f32x2*)(a.in[I_CONVW] + 2 * CD + c), w3 = *(const GAS f32x2*)(a.in[I_CONVW] + 3 * CD + c), bias = *(const GAS f32x2*)(a.in[I_CONVB] + c);
        f32x2 x0 = {0.f, 0.f}, x1 = {0.f, 0.f}, x2 = {0.f, 0.f};
        if (ch >= 256) { const float* sp = a.in[I_SCONV] + (size_t)(ch - 256) * 3 * CD + c; x0 = *(const GAS f32x2*)sp; x1 = *(const GAS f32x2*)(sp + CD); x2 = *(const GAS f32x2*)(sp + 2 * CD); }
        else if ((ch & 127) != 0) { const bf16* pp = XBC + (size_t)(m0 - 3) * CD + c; const unsigned r0 = *(const GAS unsigned*)pp, r1 = *(const GAS unsigned*)(pp + CD), r2 = *(const GAS unsigned*)(pp + 2 * CD);
            x0 = (f32x2){bf_lo(r0), bf_hi(r0)}; x1 = (f32x2){bf_lo(r1), bf_hi(r1)}; x2 = (f32x2){bf_lo(r2), bf_hi(r2)}; }
        unsigned pkA[32], pkB[32];
        const bf16* src = XBC + (size_t)m0 * CD + c;
#pragma unroll
        for (int tb = 0; tb < 4; ++tb) { unsigned raw[16];
#pragma unroll
            for (int i = 0; i < 16; ++i) raw[i] = *(const GAS unsigned*)(src + (size_t)(tb * 16 + i) * CD);
#pragma unroll
            for (int i = 0; i < 16; i += 2) { const f32x2 xa = {bf_lo(raw[i]), bf_hi(raw[i])}, xb = {bf_lo(raw[i + 1]), bf_hi(raw[i + 1])};
                const f32x2 ta = bias + w0 * x0 + w1 * x1 + w2 * x2 + w3 * xa, tb2 = bias + w0 * x1 + w1 * x2 + w2 * xa + w3 * xb;
                x0 = x2; x1 = xa; x2 = xb;
                pkA[tb * 8 + (i >> 1)] = cvt_pk_bf16(silu_f(ta[0]), silu_f(tb2[0])); pkB[tb * 8 + (i >> 1)] = cvt_pk_bf16(silu_f(ta[1]), silu_f(tb2[1])); } }
        if (cb < 64) {
            u32x4* dst = (u32x4*)((bf16*)(a.ws + WS_XT) + ((size_t)(ch * 128 + 2 * cb + (lane >> 5)) * 64 + 2 * (lane & 31)) * 64);
#pragma unroll
            for (int i = 0; i < 8; ++i) { *(GAS u32x4*)(dst + i) = (u32x4){pkA[4 * i], pkA[4 * i + 1], pkA[4 * i + 2], pkA[4 * i + 3]}; *(GAS u32x4*)(dst + 8 + i) = (u32x4){pkB[4 * i], pkB[4 * i + 1], pkB[4 * i + 2], pkB[4 * i + 3]}; }
        } else {
            const int q = cb - 64, isC = q >= 8, g = q & 7, n = 2 * lane;
            unsigned* nat = (unsigned*)((bf16*)(a.ws + (isC ? WS_CN : WS_BN)) + (size_t)(ch * 8 + g) * 8192 + n);
#pragma unroll
            for (int i = 0; i < 32; ++i) { *(GAS unsigned*)(nat + (size_t)(2 * i) * 64) = (pkA[i] & 0xffffu) | (pkB[i] << 16); *(GAS unsigned*)(nat + (size_t)(2 * i + 1) * 64) = (pkA[i] >> 16) | (pkB[i] & 0xffff0000u); }
            if (!isC) { u32x4* dst = (u32x4*)((bf16*)(a.ws + WS_BT) + (size_t)(ch * 8 + g) * 8192 + (size_t)n * 64);
#pragma unroll
                for (int i = 0; i < 8; ++i) { *(GAS u32x4*)(dst + i) = (u32x4){pkA[4 * i], pkA[4 * i + 1], pkA[4 * i + 2], pkA[4 * i + 3]}; *(GAS u32x4*)(dst + 8 + i) = (u32x4){pkB[4 * i], pkB[4 * i + 1], pkB[4 * i + 2], pkB[4 * i + 3]}; } }
        }
    }
}

constexpr int L_BN = 0, L_CN = 17408, L_BT = 34816, L_XT = 53248, L_XT2 = 62464, L_G = 71680, L_SP = 80896, L_SC = 115712, L_Z = 117888, L_Y = 127104;
static_assert(L_Y + 9216 <= LDSCTL_OFF, "SSD LDS map");
#define MFMA32(a, b, c) __builtin_amdgcn_mfma_f32_32x32x16_bf16((a), (b), (c), 0, 0, 0)
__device__ __forceinline__ float dpp_add(float v, float x) { return v + x; }
__device__ __forceinline__ float wave_incl_scan(float v) {
#define DPPF(x, ctrl, rmask, bc) __builtin_bit_cast(float, __builtin_amdgcn_update_dpp(0, __builtin_bit_cast(int, (x)), (ctrl), (rmask), 0xf, (bc)))
    v += DPPF(v, 0x111, 0xf, true); v += DPPF(v, 0x112, 0xf, true); v += DPPF(v, 0x114, 0xf, true); v += DPPF(v, 0x118, 0xf, true);
    v += DPPF(v, 0x142, 0xa, false); v += DPPF(v, 0x143, 0xc, false);
#undef DPPF
    return v;
}
__device__ __forceinline__ void ssd_scan(LAS float* SC, float dtv, float a_h, int lane) {
    const float v = wave_incl_scan(dtv * a_h);
    const float tot = __builtin_bit_cast(float, __builtin_amdgcn_readlane(__builtin_bit_cast(int, v), 63));
    SC[lane] = v; SC[64 + lane] = dtv; SC[128 + lane] = dtv * __expf(tot - v); SC[192 + lane] = __expf(v); if (lane == 0) SC[256] = __expf(tot);
}
template <int PMODE> __device__ __forceinline__ void ssd_unit(const Args& a, LAS unsigned char* L, int tid, int ch0, int NC, int m0, int hd, const float* s_init, float* s_out, const bool pcs) {
    constexpr size_t SSTR = (size_t)128 * 8192;
    asm volatile("" : "+v"(tid));
    const int lane = tid & 63, wid = __builtin_amdgcn_readfirstlane(tid >> 6), r32 = lane & 31, hi = lane >> 5, g = hd >> 4;
    const float a_h = -expf(a.in[I_ALOG][hd]), dsk = a.in[I_DSKIP][hd];
    const unsigned char* gBN = a.ws + WS_BN; const unsigned char* gCN = a.ws + WS_CN; const unsigned char* gBT = a.ws + WS_BT; const unsigned char* gXT = a.ws + WS_XT;
    const float* DT = (const float*)(a.ws + WS_DT); const bf16* ZM = (const bf16*)(a.ws + WS_ZM); bf16* YM = (bf16*)(a.ws + (PMODE ? WS_XBC + 64 * MiB : WS_YM));
    u32x4 sBN[2], sCN[2], sBT[2], sXT, sZ; float dtn = 0.f;
#define SSD_ISSUE(ch) do { const size_t tg = (size_t)((ch) * 8 + g) * 16384; _Pragma("unroll") for (int i = 0; i < 2; ++i) { const size_t o = tg + (size_t)(tid + 512 * i) * 16; \
        sBN[i] = *(const GAS u32x4*)(gBN + o); sCN[i] = *(const GAS u32x4*)(gCN + o); sBT[i] = *(const GAS u32x4*)(gBT + o); } \
        sXT = *(const GAS u32x4*)(gXT + (size_t)((ch) * 128 + hd) * 8192 + (size_t)tid * 16); \
        sZ = *(const GAS u32x4*)(ZM + (size_t)(m0 + ((ch) - ch0) * 64 + (tid >> 3)) * DI + hd * 64 + (tid & 7) * 8); } while (0)
#define SSD_COMMIT() do { _Pragma("unroll") for (int i = 0; i < 2; ++i) { const int idx = tid + 512 * i; \
        *(LAS u32x4*)(L + L_BN + (idx >> 4) * 272 + (idx & 15) * 16) = sBN[i]; *(LAS u32x4*)(L + L_CN + (idx >> 4) * 272 + (idx & 15) * 16) = sCN[i]; \
        *(LAS u32x4*)(L + L_BT + (idx >> 3) * 144 + (idx & 7) * 16) = sBT[i]; } \
        *(LAS u32x4*)(L + L_XT + (tid >> 3) * 144 + (tid & 7) * 16) = sXT; *(LAS u32x4*)(L + L_Z + (tid >> 3) * 144 + (tid & 7) * 16) = sZ; } while (0)
    f32x16 st[2], sn[2];
    int sofs = r32 * 128 + ((wid - 4) & 3) * 32 + 4 * hi; asm volatile("" : "+v"(sofs));
#pragma unroll
    for (int r = 0; r < 16; ++r) { st[0][r] = 0.f; st[1][r] = 0.f; sn[0][r] = 0.f; sn[1][r] = 0.f; }
    LBAR();
    SSD_ISSUE(ch0);
    if (wid == 4) ssd_scan((LAS float*)(L + L_SC), *(const GAS float*)(DT + (size_t)(m0 + lane) * NH + hd), a_h, lane);
    if (wid >= 4) { const int nb = wid - 4;
        if (s_init) {
#pragma unroll
            for (int pb = 0; pb < 2; ++pb)
#pragma unroll
                for (int g4 = 0; g4 < 4; ++g4) { const f32x4 v = *(const GAS f32x4*)(s_init + sofs + pb * 4096 + 8 * g4);
                    st[pb][4 * g4] = v[0]; st[pb][4 * g4 + 1] = v[1]; st[pb][4 * g4 + 2] = v[2]; st[pb][4 * g4 + 3] = v[3]; }
        }
#pragma unroll
        for (int pb = 0; pb < 2; ++pb)
#pragma unroll
            for (int g4 = 0; g4 < 4; ++g4) { u32x2 w; w.x = cvt_pk_bf16(st[pb][4 * g4], st[pb][4 * g4 + 1]); w.y = cvt_pk_bf16(st[pb][4 * g4 + 2], st[pb][4 * g4 + 3]);
                *(LAS u32x2*)(L + L_SP + (pb * 32 + r32) * 272 + (nb * 32 + 8 * g4 + 4 * hi) * 2) = w; }
    }
    SSD_COMMIT();
    LBAR();
    int cur = 0;
    for (int c = 0; c < NC; ++c) {
        const int mc = m0 + c * 64; const bool has_next = c + 1 < NC;
        LAS float* SC = (LAS float*)(L + L_SC) + cur * 272;
        if (has_next && PMODE != 1) {
            if (pcs && wid >= 4) { const float* sp = s_init + (size_t)(c + 1) * SSTR;
#pragma unroll
                for (int pb = 0; pb < 2; ++pb)
#pragma unroll
                    for (int g4 = 0; g4 < 4; ++g4) { const f32x4 v = *(const GAS f32x4*)(sp + sofs + pb * 4096 + 8 * g4);
                        sn[pb][4 * g4] = v[0]; sn[pb][4 * g4 + 1] = v[1]; sn[pb][4 * g4 + 2] = v[2]; sn[pb][4 * g4 + 3] = v[3]; } }
            SSD_ISSUE(ch0 + c + 1); if (wid == 4) dtn = *(const GAS float*)(DT + (size_t)(mc + 64 + lane) * NH + hd); }
        if (wid < 4) {
            const int lb = wid >> 1, pb = wid & 1;
            if (wid != 1) { const int sb = wid & 1, l = lb * 32 + r32; f32x16 cb;
#pragma unroll
                for (int r = 0; r < 16; ++r) cb[r] = 0.f;
                LAS const unsigned char* pa = L + L_BN + (sb * 32 + r32) * 272 + hi * 16; LAS const unsigned char* pbb = L + L_CN + (lb * 32 + r32) * 272 + hi * 16;
#pragma unroll
                for (int kh = 0; kh < 2; ++kh) { bf16x8 fa[4], fb[4];
#pragma unroll
                    for (int k = 0; k < 4; ++k) { fa[k] = *(LAS const bf16x8*)(pa + (kh * 4 + k) * 32); fb[k] = *(LAS const bf16x8*)(pbb + (kh * 4 + k) * 32); }
                    __builtin_amdgcn_sched_barrier(0);
#pragma unroll
                    for (int k = 0; k < 4; ++k) cb = MFMA32(fa[k], fb[k], cb);
                    __builtin_amdgcn_sched_barrier(0); }
                const float al = SC[l];
#pragma unroll
                for (int g4 = 0; g4 < 4; ++g4) { const int s0 = sb * 32 + 8 * g4 + 4 * hi; const f32x4 as = *(LAS const f32x4*)(SC + s0), ds = *(LAS const f32x4*)(SC + 64 + s0); float gv[4];
#pragma unroll
                    for (int e = 0; e < 4; ++e) { const float t = cb[4 * g4 + e] * __expf(al - as[e]) * ds[e]; gv[e] = (s0 + e <= l) ? t : 0.f; }
                    u32x2 w; w.x = cvt_pk_bf16(gv[0], gv[1]); w.y = cvt_pk_bf16(gv[2], gv[3]); *(LAS u32x2*)(L + L_G + l * 144 + s0 * 2) = w; } }
        } else { const int t2 = tid - 256, p = t2 >> 2, seg = t2 & 3;
            LAS const unsigned char* src = L + L_XT + p * 144 + seg * 32; const u32x4 v0 = *(LAS const u32x4*)src, v1 = *(LAS const u32x4*)(src + 16);
            LAS const f32x4* wp = (LAS const f32x4*)(SC + 128 + seg * 16); const f32x4 wa = wp[0], wb = wp[1], wc4 = wp[2], wd = wp[3];
            u32x4 o0, o1;
            o0.x = cvt_pk_bf16(bf_lo(v0.x) * wa[0], bf_hi(v0.x) * wa[1]); o0.y = cvt_pk_bf16(bf_lo(v0.y) * wa[2], bf_hi(v0.y) * wa[3]); o0.z = cvt_pk_bf16(bf_lo(v0.z) * wb[0], bf_hi(v0.z) * wb[1]); o0.w = cvt_pk_bf16(bf_lo(v0.w) * wb[2], bf_hi(v0.w) * wb[3]);
            o1.x = cvt_pk_bf16(bf_lo(v1.x) * wc4[0], bf_hi(v1.x) * wc4[1]); o1.y = cvt_pk_bf16(bf_lo(v1.y) * wc4[2], bf_hi(v1.y) * wc4[3]); o1.z = cvt_pk_bf16(bf_lo(v1.z) * wd[0], bf_hi(v1.z) * wd[1]); o1.w = cvt_pk_bf16(bf_lo(v1.w) * wd[2], bf_hi(v1.w) * wd[3]);
            LAS unsigned char* dst = L + L_XT2 + p * 144 + seg * 32; *(LAS u32x4*)dst = o0; *(LAS u32x4*)(dst + 16) = o1; }
        LBAR();
        if (wid < 4) { const int lb = wid >> 1, pb = wid & 1; f32x16 y;
#pragma unroll
            for (int r = 0; r < 16; ++r) y[r] = 0.f;
            { LAS const unsigned char* pa = L + L_CN + (lb * 32 + r32) * 272 + hi * 16; LAS const unsigned char* pbb = L + L_SP + cur * 17408 + (pb * 32 + r32) * 272 + hi * 16;
#pragma unroll
              for (int kh = 0; kh < 2; ++kh) { bf16x8 fa[4], fb[4];
#pragma unroll
                  for (int k = 0; k < 4; ++k) { fa[k] = *(LAS const bf16x8*)(pa + (kh * 4 + k) * 32); fb[k] = *(LAS const bf16x8*)(pbb + (kh * 4 + k) * 32); }
                  __builtin_amdgcn_sched_barrier(0);
#pragma unroll
                  for (int k = 0; k < 4; ++k) y = MFMA32(fa[k], fb[k], y);
                  __builtin_amdgcn_sched_barrier(0); } }
            bf16x8 ga[4], xb[4];
            { LAS const unsigned char* pa = L + L_G + (lb * 32 + r32) * 144 + hi * 16; LAS const unsigned char* pbb = L + L_XT + (pb * 32 + r32) * 144 + hi * 16;
              ga[0] = *(LAS const bf16x8*)(pa); xb[0] = *(LAS const bf16x8*)(pbb); ga[1] = *(LAS const bf16x8*)(pa + 32); xb[1] = *(LAS const bf16x8*)(pbb + 32);
              if (lb) { ga[2] = *(LAS const bf16x8*)(pa + 64); xb[2] = *(LAS const bf16x8*)(pbb + 64); ga[3] = *(LAS const bf16x8*)(pa + 96); xb[3] = *(LAS const bf16x8*)(pbb + 96); } }
#pragma unroll
            for (int g4 = 0; g4 < 4; ++g4) { const f32x4 e4 = *(LAS const f32x4*)(SC + 192 + lb * 32 + 8 * g4 + 4 * hi); y[4 * g4] *= e4[0]; y[4 * g4 + 1] *= e4[1]; y[4 * g4 + 2] *= e4[2]; y[4 * g4 + 3] *= e4[3]; }
            y = MFMA32(ga[0], xb[0], y); y = MFMA32(ga[1], xb[1], y);
            if (lb) { y = MFMA32(ga[2], xb[2], y); y = MFMA32(ga[3], xb[3], y); }
            const int p = pb * 32 + r32;
#pragma unroll
            for (int g4 = 0; g4 < 4; ++g4) { const int l0 = lb * 32 + 8 * g4 + 4 * hi; const u32x2 xv = *(LAS const u32x2*)(L + L_XT + p * 144 + l0 * 2);
                const float xe[4] = {bf_lo(xv.x), bf_hi(xv.x), bf_lo(xv.y), bf_hi(xv.y)};
#pragma unroll
                for (int e = 0; e < 4; ++e) { const float zz = bf2f(*(LAS const bf16*)(L + L_Z + (l0 + e) * 144 + p * 2)); const float yv = (y[4 * g4 + e] + dsk * xe[e]) * zz; *(LAS bf16*)(L + L_Y + (l0 + e) * 144 + p * 2) = f2bf(yv); } }
        } else { const int nb = wid - 4; const float dA = SC[256];
#pragma unroll
            for (int r = 0; r < 16; ++r) { st[0][r] *= dA; st[1][r] *= dA; }
            LAS const unsigned char* pa = L + L_BT + (nb * 32 + r32) * 144 + hi * 16; bf16x8 af[4], x0f[4], x1f[4];
#pragma unroll
            for (int ks = 0; ks < 4; ++ks) { af[ks] = *(LAS const bf16x8*)(pa + ks * 32); x0f[ks] = *(LAS const bf16x8*)(L + L_XT2 + r32 * 144 + hi * 16 + ks * 32); x1f[ks] = *(LAS const bf16x8*)(L + L_XT2 + (32 + r32) * 144 + hi * 16 + ks * 32); }
            __builtin_amdgcn_sched_barrier(0);
#pragma unroll
            for (int ks = 0; ks < 4; ++ks) { st[0] = MFMA32(af[ks], x0f[ks], st[0]); st[1] = MFMA32(af[ks], x1f[ks], st[1]); }
            __builtin_amdgcn_sched_barrier(0);
            if (wid == 4 && has_next) ssd_scan((LAS float*)(L + L_SC) + (cur ^ 1) * 272, dtn, a_h, lane);
            if (pcs) { float* so = s_out + (size_t)c * SSTR;
#pragma unroll
                for (int pb = 0; pb < 2; ++pb)
#pragma unroll
                    for (int g4 = 0; g4 < 4; ++g4) *(GAS f32x4*)(so + sofs + pb * 4096 + 8 * g4) = (f32x4){st[pb][4 * g4], st[pb][4 * g4 + 1], st[pb][4 * g4 + 2], st[pb][4 * g4 + 3]};
                st[0] = sn[0]; st[1] = sn[1]; }
#pragma unroll
            for (int pb = 0; pb < 2; ++pb)
#pragma unroll
                for (int g4 = 0; g4 < 4; ++g4) { u32x2 w; w.x = cvt_pk_bf16(st[pb][4 * g4], st[pb][4 * g4 + 1]); w.y = cvt_pk_bf16(st[pb][4 * g4 + 2], st[pb][4 * g4 + 3]);
                    *(LAS u32x2*)(L + L_SP + (cur ^ 1) * 17408 + (pb * 32 + r32) * 272 + (nb * 32 + 8 * g4 + 4 * hi) * 2) = w; }
        }
        LBAR();
        *(GAS u32x4*)(YM + (size_t)(mc + (tid >> 3)) * DI + hd * 64 + (tid & 7) * 8) = *(LAS const u32x4*)(L + L_Y + (tid >> 3) * 144 + (tid & 7) * 16);
        if (has_next) { SSD_COMMIT(); }
        LBAR();
        cur ^= 1;
    }
    if (!pcs && wid >= 4) { const int nb = wid - 4;
#pragma unroll
        for (int pb = 0; pb < 2; ++pb)
#pragma unroll
            for (int g4 = 0; g4 < 4; ++g4) *(GAS f32x4*)(s_out + sofs + pb * 4096 + 8 * g4) = (f32x4){st[pb][4 * g4], st[pb][4 * g4 + 1], st[pb][4 * g4 + 2], st[pb][4 * g4 + 3]};
    }
#undef SSD_ISSUE
#undef SSD_COMMIT
}

constexpr int A_K = 0, A_V = 24576, A_WS = 73728, A_Q = 75776;
__device__ __forceinline__ void glds16(const void* gsrc, unsigned lds_dst) { unsigned keep;
    asm volatile("s_mov_b32 %0, m0\n\ts_mov_b32 m0, %2\n\ts_nop 0\n\tglobal_load_lds_dwordx4 %1, off\n\ts_mov_b32 m0, %0" : "=&s"(keep) : "v"(gsrc), "s"(lds_dst) : "memory"); }
__device__ __forceinline__ void glds16s(const void* sbase, unsigned voff, unsigned lds_dst) { unsigned keep;
    asm volatile("s_mov_b32 %0, m0\n\ts_mov_b32 m0, %3\n\ts_nop 0\n\tglobal_load_lds_dwordx4 %1, %2\n\ts_mov_b32 m0, %0" : "=&s"(keep) : "v"(voff), "s"(sbase), "s"(lds_dst) : "memory"); }
#define AWAIT_BAR(N) asm volatile("s_waitcnt vmcnt(" #N ") lgkmcnt(0)\n\ts_barrier" ::: "memory")
#define ABAR() asm volatile("s_waitcnt lgkmcnt(0)\n\ts_barrier" ::: "memory")
__device__ __forceinline__ float max3f(float a, float b, float c) { float r; asm("v_max3_f32 %0, %1, %2, %3" : "=v"(r) : "v"(a), "v"(b), "v"(c)); return r; }
__device__ __forceinline__ int crow(int r, int hi) { return (r & 3) + 8 * (r >> 2) + 4 * hi; }
template <int PMODE> __device__ __forceinline__ void attn_unit(const bf16* Kb, const bf16* Vb, int NT, const bf16* Qb, bf16* Ya, const bf16* Za, const float* anw, float* park, float lam, LAS unsigned char* shm, int tid,
                                                                     const bf16* Kbn, const bf16* Vbn, int NTn, const bf16* Qbn, bool pre, bf16x8 (&qx)[4]) {
    const int lane = tid & 63, r32 = lane & 31, hi = lane >> 5, wid = __builtin_amdgcn_readfirstlane(tid >> 6), rep = wid >> 1, th = wid & 1, half = wid >> 2;
    const unsigned lds0 = (unsigned)(uintptr_t)shm;
    LAS float* wsf = (LAS float*)(shm + A_WS) + wid * 64;
    const int vb0 = (int)(lds0 + A_V) + ((lane >> 4) & 1) * 32 + (lane & 3) * 8 + (4 * hi + ((lane & 15) >> 2)) * 64;
    for (int c = 0; c < 2; ++c) {
        const unsigned kvoff = (unsigned)(lane * 2048 + wid * 16 + c * 128);
        const unsigned vvoff = (unsigned)((16 * (wid & 3) + (lane >> 2)) * 2048 + (wid >> 2) * 64 + (lane & 3) * 16);
        const unsigned kdst = lds0 + A_K + wid * 1024, vdst0 = lds0 + A_V + wid * 1024, vdst1 = vdst0 + 8192;
#define ADMA_K(t, slot) glds16s((const char*)Kb + (size_t)(t) * 131072, kvoff, (unsigned)__builtin_amdgcn_readfirstlane(kdst + (slot) * 8192))
#define ADMA_V(t, slot) do { glds16s((const char*)Vb + (size_t)(t) * 131072, vvoff, (unsigned)__builtin_amdgcn_readfirstlane(vdst0 + (slot) * 16384)); glds16s((const char*)Vb + (size_t)(t) * 131072 + 128, vvoff, (unsigned)__builtin_amdgcn_readfirstlane(vdst1 + (slot) * 16384)); } while (0)
#define KLOAD(slot) do { LAS const unsigned char* kb_ = shm + A_K + (slot) * 8192 + hi * 1024 + r32 * 16; _Pragma("unroll") for (int d0 = 0; d0 < 4; ++d0) { kf[2 * d0] = *(LAS const bf16x8*)(kb_ + d0 * 2048); kf[2 * d0 + 1] = *(LAS const bf16x8*)(kb_ + d0 * 2048 + 512); } } while (0)
#define QLOAD() do { _Pragma("unroll") for (int d0 = 0; d0 < 4; ++d0) qr[d0] = *(LAS const bf16x8*)(qlds + d0 * 1024); } while (0)
#define QKT() do { p0 = MFMA32(kf[0], qr[0], zero16); p1 = MFMA32(kf[1], qr[0], zero16); _Pragma("unroll") for (int d0 = 1; d0 < 4; ++d0) { p0 = MFMA32(kf[2 * d0], qr[d0], p0); p1 = MFMA32(kf[2 * d0 + 1], qr[d0], p1); } } while (0)
        AWAIT_BAR(0);
        const bool have = (c == 0) && pre;
        if (!have) { ADMA_K(0, 0); ADMA_V(0, 0); if (NT > 1) { ADMA_K(1, 1); ADMA_V(1, 1); } if (NT > 2) ADMA_K(2, 2); }
        LAS unsigned char* qlds; { bf16x8 qr[4];
        if (have) {
#pragma unroll
            for (int d0 = 0; d0 < 4; ++d0) qr[d0] = qx[d0];
        } else {
#pragma unroll
            for (int d0 = 0; d0 < 4; ++d0) qr[d0] = *(const GAS bf16x8*)(Qb + (size_t)(32 * th + r32) * D + rep * 128 + c * 64 + d0 * 16 + hi * 8);
        }
        asm volatile("" : "+v"(qr[0]), "+v"(qr[1]), "+v"(qr[2]), "+v"(qr[3]));
        qlds = shm + A_Q + wid * 4096 + lane * 16;
#pragma unroll
        for (int d0 = 0; d0 < 4; ++d0) *(LAS bf16x8*)(qlds + d0 * 1024) = qr[d0]; }
        f32x16 o[4];
#pragma unroll
        for (int d = 0; d < 4; ++d)
#pragma unroll
            for (int r = 0; r < 16; ++r) o[d][r] = 0.f;
        float mref = 0.f, lsum = 0.f; int anyref = 0;
        f32x16 pA0, pA1, pB0, pB1;
        const f32x16 zero16 = {0.f, 0.f, 0.f, 0.f, 0.f, 0.f, 0.f, 0.f, 0.f, 0.f, 0.f, 0.f, 0.f, 0.f, 0.f, 0.f};
        int s0 = 0, s1 = 1, s2 = 2;
        AWAIT_BAR(0);
        { bf16x8 kf[8], qr[4]; KLOAD(0); QLOAD(); __builtin_amdgcn_sched_barrier(0);
          pA0 = MFMA32(kf[0], qr[0], zero16); pA1 = MFMA32(kf[1], qr[0], zero16);
#pragma unroll
          for (int d0 = 1; d0 < 4; ++d0) { pA0 = MFMA32(kf[2 * d0], qr[d0], pA0); pA1 = MFMA32(kf[2 * d0 + 1], qr[d0], pA1); } }
        if (half == 1) ABAR();
#define SM_GRP(g, PC0, PC1, PN0, PN1, WITH_QK, SUBM) do { \
            if (WITH_QK) { if ((g) + 2 < 8) { kf[((g) + 2) & 7] = *(LAS const bf16x8*)(kb_ + (((g) + 2) >> 1) * 2048 + (((g) + 2) & 1) * 512); if ((((g) + 2) & 1) == 0) qr[(((g) + 2) >> 1) & 3] = *(LAS const bf16x8*)(qlds + (((g) + 2) >> 1) * 1024); } \
                           if ((g) == 0) PN0 = MFMA32(kf[0], qr[0], zero16); else if ((g) == 1) PN1 = MFMA32(kf[1], qr[0], zero16); else if (((g) & 1) == 0) PN0 = MFMA32(kf[g], qr[(g) >> 1], PN0); else PN1 = MFMA32(kf[g], qr[(g) >> 1], PN1); } \
            if (SUBM) { PC0[2 * (g)] -= mref; PC0[2 * (g) + 1] -= mref; PC1[2 * (g)] -= mref; PC1[2 * (g) + 1] -= mref; } \
            PC0[2 * (g)] = __builtin_amdgcn_exp2f(PC0[2 * (g)]); PC0[2 * (g) + 1] = __builtin_amdgcn_exp2f(PC0[2 * (g) + 1]); PC1[2 * (g)] = __builtin_amdgcn_exp2f(PC1[2 * (g)]); PC1[2 * (g) + 1] = __builtin_amdgcn_exp2f(PC1[2 * (g) + 1]); \
            ps2 += (f32x2){PC0[2 * (g)], PC0[2 * (g) + 1]}; ps2 += (f32x2){PC1[2 * (g)], PC1[2 * (g) + 1]}; \
            pw[(g) >> 2][(g) & 3] = cvt_pk_bf16(PC0[2 * (g)], PC0[2 * (g) + 1]); pw[2 + ((g) >> 2)][(g) & 3] = cvt_pk_bf16(PC1[2 * (g)], PC1[2 * (g) + 1]); \
            __builtin_amdgcn_sched_barrier(0); } while (0)
#define SM_ALL(PC0, PC1, PN0, PN1, WITH_QK, SUBM) do { SM_GRP(0, PC0, PC1, PN0, PN1, WITH_QK, SUBM); SM_GRP(1, PC0, PC1, PN0, PN1, WITH_QK, SUBM); SM_GRP(2, PC0, PC1, PN0, PN1, WITH_QK, SUBM); SM_GRP(3, PC0, PC1, PN0, PN1, WITH_QK, SUBM); \
            SM_GRP(4, PC0, PC1, PN0, PN1, WITH_QK, SUBM); SM_GRP(5, PC0, PC1, PN0, PN1, WITH_QK, SUBM); SM_GRP(6, PC0, PC1, PN0, PN1, WITH_QK, SUBM); SM_GRP(7, PC0, PC1, PN0, PN1, WITH_QK, SUBM); } while (0)
#define ATT_STEP(t, PC0, PC1, PN0, PN1) do { \
              \
            if (!(PMODE & 1) && half == 1) { if ((t) + 3 < NT) ADMA_K((t) + 3, s0); if ((t) + 2 < NT) ADMA_V((t) + 2, s2); } \
            bf16x8 kf[8], qr[4]; LAS const unsigned char* kb_ = shm + A_K + s1 * 8192 + hi * 1024 + r32 * 16; \
            kf[0] = *(LAS const bf16x8*)(kb_); kf[1] = *(LAS const bf16x8*)(kb_ + 512); qr[0] = *(LAS const bf16x8*)(qlds);     \
            asm volatile("s_nop 15\n\ts_nop 7" : "+v"(PC0), "+v"(PC1));        \
            float rm = max3f(PC0[0], PC0[1], PC1[0]), rm2 = max3f(PC0[2], PC0[3], PC1[1]); rm = max3f(rm, PC1[2], PC1[3]); \
            _Pragma("unroll") for (int r = 4; r < 16; r += 4) { rm = max3f(rm, PC0[r], PC0[r + 1]); rm2 = max3f(rm2, PC0[r + 2], PC0[r + 3]); rm = max3f(rm, PC1[r], PC1[r + 1]); rm2 = max3f(rm2, PC1[r + 2], PC1[r + 3]); } \
            rm = max3f(rm, rm2, rm2); \
            { auto rr = __builtin_amdgcn_permlane32_swap(__float_as_uint(rm), __float_as_uint(rm), false, false); rm = fmaxf(__uint_as_float(rr[0]), __uint_as_float(rr[1])); } \
            { bool need_ = rm > mref + 16.f; if ((t) == 0) need_ = need_ || (rm < -16.f);     \
              if (__any(need_)) { \
                const float mnew = (t) == 0 ? (need_ ? rm : 0.f) : fmaxf(rm, mref), alpha = (t) == 0 ? 0.f : __builtin_amdgcn_exp2f(mref - mnew); \
                lsum *= alpha; mref = mnew; anyref = 1; \
                if (hi == 0) wsf[r32] = alpha; \
                asm volatile("s_waitcnt lgkmcnt(0)" ::: "memory"); \
                _Pragma("unroll") for (int g4 = 0; g4 < 4; ++g4) { const f32x4 f = *(LAS const f32x4*)(wsf + 8 * g4 + 4 * hi); \
                    _Pragma("unroll") for (int d = 0; d < 4; ++d) { o[d][4 * g4] *= f[0]; o[d][4 * g4 + 1] *= f[1]; o[d][4 * g4 + 2] *= f[2]; o[d][4 * g4 + 3] *= f[3]; } } \
              } } \
            f32x2 ps2 = {0.f, 0.f}; u32x4 pw[4]; \
            __builtin_amdgcn_sched_barrier(0); \
            if (__builtin_amdgcn_readfirstlane(anyref)) SM_ALL(PC0, PC1, PN0, PN1, true, true); else SM_ALL(PC0, PC1, PN0, PN1, true, false);     \
            const float ps = ps2[0] + ps2[1]; \
            lsum += ps; \
            bf16x8 pa[4]; pa[0] = __builtin_bit_cast(bf16x8, pw[0]); pa[1] = __builtin_bit_cast(bf16x8, pw[1]); pa[2] = __builtin_bit_cast(bf16x8, pw[2]); pa[3] = __builtin_bit_cast(bf16x8, pw[3]); \
            if (!(PMODE & 8)) { if (half == 0) ABAR(); else { if ((t) + 3 < NT) AWAIT_BAR(3); else AWAIT_BAR(0); } } \
              \
            if (!(PMODE & 1) && half == 0) { if ((t) + 3 < NT) ADMA_K((t) + 3, s0); if ((t) + 2 < NT) ADMA_V((t) + 2, s2); } \
            { const int vb = vb0 + s0 * 16384; typedef short s16x4 __attribute__((ext_vector_type(4))); s16x4 vlo[4], vhh[4];     \
              VRD1(0); VRD1(1); VRD1(2); VRD1(3); \
              VSTEP(0, 6); VSTEP(1, 6); VSTEP(2, 6); VSTEP(3, 6); VSTEP(4, 6); VSTEP(5, 6); VSTEP(6, 6); VSTEP(7, 6); VSTEP(8, 6); VSTEP(9, 6); VSTEP(10, 6); VSTEP(11, 6); VSTEP(12, 6); \
              VSTEP(13, 4); VSTEP(14, 2); VSTEP(15, 0); } \
            if (!(PMODE & 8)) { if (half == 0) { if ((t) + 3 < NT) AWAIT_BAR(3); else AWAIT_BAR(0); } else ABAR(); } \
            { const int tmp = s0; s0 = s1; s1 = s2; s2 = tmp; } } while (0)
#define VRD1(i) do { asm volatile("ds_read_b64_tr_b16 %0,%1 offset:%c2" : "=&v"(vlo[(i) & 3]) : "v"(vb), "i"(((i) >> 2) * 4096 + ((i) & 3) * 1024) : "memory"); \
                     asm volatile("ds_read_b64_tr_b16 %0,%1 offset:%c2" : "=&v"(vhh[(i) & 3]) : "v"(vb), "i"(((i) >> 2) * 4096 + ((i) & 3) * 1024 + 512) : "memory"); } while (0)
#define VSTEP(i, N) do { asm volatile("s_waitcnt lgkmcnt(" #N ")" : "+v"(vlo[(i) & 3]), "+v"(vhh[(i) & 3]) :: "memory"); \
            { const bf16x8 vf = (bf16x8){vlo[(i) & 3][0], vlo[(i) & 3][1], vlo[(i) & 3][2], vlo[(i) & 3][3], vhh[(i) & 3][0], vhh[(i) & 3][1], vhh[(i) & 3][2], vhh[(i) & 3][3]}; o[(i) >> 2] = MFMA32(pa[(i) & 3], vf, o[(i) >> 2]); } \
            if ((i) + 4 < 16) VRD1((i) + 4); } while (0)
        int t = 0;
        for (; t + 1 < NT; t += 2) { ATT_STEP(t, pA0, pA1, pB0, pB1); ATT_STEP(t + 1, pB0, pB1, pA0, pA1); }
        if (t < NT) ATT_STEP(t, pA0, pA1, pB0, pB1);
#undef VRD1
#undef VSTEP
#undef ATT_STEP
#undef SM_GRP
#undef SM_ALL
        if (half == 0) ABAR();
        { auto rr = __builtin_amdgcn_permlane32_swap(__float_as_uint(lsum), __float_as_uint(lsum), false, false); lsum = __uint_as_float(rr[0]) + __uint_as_float(rr[1]); }
        if (hi == 0) wsf[r32] = lsum;
        asm volatile("s_waitcnt lgkmcnt(0)" ::: "memory");
        float rli[16];
#pragma unroll
        for (int g4 = 0; g4 < 4; ++g4) { const f32x4 f = *(LAS const f32x4*)(wsf + 8 * g4 + 4 * hi); rli[4 * g4] = __builtin_amdgcn_rcpf(f[0]); rli[4 * g4 + 1] = __builtin_amdgcn_rcpf(f[1]); rli[4 * g4 + 2] = __builtin_amdgcn_rcpf(f[2]); rli[4 * g4 + 3] = __builtin_amdgcn_rcpf(f[3]); }
        const __amdgpu_buffer_rsrc_t prs = __builtin_amdgcn_make_buffer_rsrc((void*)park, 0, 32768 * 4, 0x00020000);
        unsigned toff = (unsigned)tid * 4u; asm volatile("" : "+v"(toff));
        if (c == 0) {
#pragma unroll
            for (int d = 0; d < 4; ++d)
#pragma unroll
                for (int r = 0; r < 16; ++r) __builtin_amdgcn_raw_buffer_store_b32(__float_as_uint(o[d][r] * rli[r]), prs, toff, (d * 16 + r) * 2048, 0);
        } else {
            const __amdgpu_buffer_rsrc_t yrs = __builtin_amdgcn_make_buffer_rsrc((void*)Ya, 0, 64 * D * 2, 0x00020000);
            const __amdgpu_buffer_rsrc_t zrs = __builtin_amdgcn_make_buffer_rsrc((void*)Za, 0, 64 * D * 2, 0x00020000);
            unsigned yoff = (unsigned)(((32 * th + 4 * hi) * D + rep * 128 + r32) * 2); asm volatile("" : "+v"(yoff));
            float ss[16];
#pragma unroll
            for (int r = 0; r < 16; ++r) ss[r] = 0.f;
#pragma unroll
            for (int d = 0; d < 4; ++d) { float pv[16];
#pragma unroll
                for (int r = 0; r < 16; ++r) pv[r] = __uint_as_float(__builtin_amdgcn_raw_buffer_load_b32(prs, toff, (d * 16 + r) * 2048, 0));
#pragma unroll
                for (int r = 0; r < 16; ++r) { o[d][r] = pv[r] - lam * (o[d][r] * rli[r]); ss[r] += o[d][r] * o[d][r]; } }
            if (NTn > 0) {
                const unsigned kvn = (unsigned)(lane * 2048 + wid * 16);
                glds16s((const char*)Kbn, kvn, (unsigned)__builtin_amdgcn_readfirstlane(kdst)); glds16s((const char*)Vbn, vvoff, (unsigned)__builtin_amdgcn_readfirstlane(vdst0)); glds16s((const char*)Vbn + 128, vvoff, (unsigned)__builtin_amdgcn_readfirstlane(vdst1));
                if (NTn > 1) { glds16s((const char*)Kbn + 131072, kvn, (unsigned)__builtin_amdgcn_readfirstlane(kdst + 8192)); glds16s((const char*)Vbn + 131072, vvoff, (unsigned)__builtin_amdgcn_readfirstlane(vdst0 + 16384)); glds16s((const char*)Vbn + 131072 + 128, vvoff, (unsigned)__builtin_amdgcn_readfirstlane(vdst1 + 16384)); }
                if (NTn > 2) glds16s((const char*)Kbn + 2 * 131072, kvn, (unsigned)__builtin_amdgcn_readfirstlane(kdst + 2 * 8192));
#pragma unroll
                for (int d0 = 0; d0 < 4; ++d0) qx[d0] = *(const GAS bf16x8*)(Qbn + (size_t)(32 * th + r32) * D + rep * 128 + d0 * 16 + hi * 8);
            }
#pragma unroll
            for (int r = 0; r < 16; ++r) { float v = ss[r];
#define DPPA(x, ctrl) __builtin_bit_cast(float, __builtin_amdgcn_update_dpp(0, __builtin_bit_cast(int, (x)), (ctrl), 0xf, 0xf, true))
                v += DPPA(v, 0xB1); v += DPPA(v, 0x4E); v += DPPA(v, 0x141); v += DPPA(v, 0x140);
#undef DPPA
                v += __builtin_bit_cast(float, __builtin_amdgcn_ds_swizzle(__builtin_bit_cast(int, v), 0x401F));
                ss[r] = 0.8f * __builtin_amdgcn_rsqf(v * (1.f / 128.f) + EPS); }
#pragma unroll
            for (int d = 0; d < 4; ++d) { unsigned short zz[16]; const float wn = anw[32 * d + r32];
#pragma unroll
                for (int r = 0; r < 16; ++r) zz[r] = (unsigned short)__builtin_amdgcn_raw_buffer_load_b16(zrs, yoff, (((r & 3) + 8 * (r >> 2)) * D + 32 * d) * 2, 0);
#pragma unroll
                for (int r = 0; r < 16; ++r) { const float y = o[d][r] * ss[r] * wn * bf2f(zz[r]);
                    __builtin_amdgcn_raw_buffer_store_b16((short)f2bf(y), yrs, yoff, (((r & 3) + 8 * (r >> 2)) * D + 32 * d) * 2, 0); } }
        }
#undef ADMA_K
#undef ADMA_V
#undef KLOAD
#undef QKT
#undef QLOAD
    }
}

__device__ __forceinline__ void phase_norm(const Args& a, int tid, int bx, int G, bool dummy = false) {
    const int lane = tid & 63, wave = tid >> 6, gw = bx * 8 + wave, NGW = G * 8;
    bf16* YM = (bf16*)(a.ws + WS_YM); bf16* YA = (bf16*)(a.ws + WS_YA); const bf16* ZA = (const bf16*)(a.ws + WS_ZA);
    for (int it = gw; it < M * 8; it += NGW) {
        const int g = it & 7; bf16* p = YM + (size_t)(it >> 3) * DI + g * 1024 + lane * 8;
        const u32x4 v0 = *(const GAS u32x4*)p, v1 = *(const GAS u32x4*)(p + 512);
        float x[16] = {bf_lo(v0.x), bf_hi(v0.x), bf_lo(v0.y), bf_hi(v0.y), bf_lo(v0.z), bf_hi(v0.z), bf_lo(v0.w), bf_hi(v0.w), bf_lo(v1.x), bf_hi(v1.x), bf_lo(v1.y), bf_hi(v1.y), bf_lo(v1.z), bf_hi(v1.z), bf_lo(v1.w), bf_hi(v1.w)};
        float s = 0.f;
#pragma unroll
        for (int i = 0; i < 16; ++i) s += x[i] * x[i];
        const float rstd = 1.f / sqrtf(wave_sum(s) * (1.f / 1024.f) + EPS);
        const float* nw = a.in[I_MNW] + g * 1024 + lane * 8;
        const f32x4 w0 = *(const GAS f32x4*)nw, w1 = *(const GAS f32x4*)(nw + 4), w2 = *(const GAS f32x4*)(nw + 512), w3 = *(const GAS f32x4*)(nw + 516);
        u32x4 o0, o1;
        o0.x = cvt_pk_bf16(x[0] * rstd * w0[0], x[1] * rstd * w0[1]); o0.y = cvt_pk_bf16(x[2] * rstd * w0[2], x[3] * rstd * w0[3]); o0.z = cvt_pk_bf16(x[4] * rstd * w1[0], x[5] * rstd * w1[1]); o0.w = cvt_pk_bf16(x[6] * rstd * w1[2], x[7] * rstd * w1[3]);
        o1.x = cvt_pk_bf16(x[8] * rstd * w2[0], x[9] * rstd * w2[1]); o1.y = cvt_pk_bf16(x[10] * rstd * w2[2], x[11] * rstd * w2[3]); o1.z = cvt_pk_bf16(x[12] * rstd * w3[0], x[13] * rstd * w3[1]); o1.w = cvt_pk_bf16(x[14] * rstd * w3[2], x[15] * rstd * w3[3]);
        bf16* pw = dummy ? p + (WS_XBC - WS_YM) / 2 : p; *(GAS u32x4*)pw = o0; *(GAS u32x4*)(pw + 512) = o1;
    }
}
__device__ __forceinline__ void phase_final(const Args& a, int tid, int bx, int G, bool dummy = false) {
    const int lane = tid & 63, wave = __builtin_amdgcn_readfirstlane(tid >> 6), gw = bx * 8 + wave, NGW = G * 8;
    f32x4 wv[16];
#pragma unroll
    for (int j = 0; j < 16; ++j) wv[j] = *(const GAS f32x4*)(a.in[I_FNW] + 4 * (64 * j + lane));
    const bool split = USE_SPLIT && G == 256;
#define FIN_LOAD(dst, row) do { const bool sp_ = split && (row) >= MP; const float* xr_ = (row) < MP ? a.in[I_XP] + (size_t)(row) * D : a.in[I_XS] + (size_t)((row) - MP) * D; \
        const float* ps_ = (const float*)(a.ws + WS_PS) + (size_t)((row) - MP) * D; const bf16* dl_ = (const bf16*)(a.ws + WS_DLT) + (size_t)(row) * D; \
        _Pragma("unroll") for (int j = 0; j < 16; ++j) { const int e = 4 * (64 * j + lane); \
            if (sp_) dst[j] = *(const GAS f32x4*)(xr_ + e) + ((*(const GAS f32x4*)(ps_ + e) + *(const GAS f32x4*)(ps_ + (size_t)MS * D + e)) + (*(const GAS f32x4*)(ps_ + (size_t)2 * MS * D + e) + *(const GAS f32x4*)(ps_ + (size_t)3 * MS * D + e))); \
            else { const u32x2 d2 = *(const GAS u32x2*)(dl_ + e); dst[j] = *(const GAS f32x4*)(xr_ + e) + (f32x4){bf_lo(d2.x), bf_hi(d2.x), bf_lo(d2.y), bf_hi(d2.y)}; } } } while (0)
    f32x4 v[16], nv[16];
    if (gw < M) FIN_LOAD(nv, gw);
    for (int row = gw; row < M; row += NGW) {
#pragma unroll
        for (int j = 0; j < 16; ++j) v[j] = nv[j];
        if (row + NGW < M) FIN_LOAD(nv, row + NGW);
        float s = 0.f;
#pragma unroll
        for (int j = 0; j < 16; ++j) s += (v[j][0] * v[j][0] + v[j][1] * v[j][1]) + (v[j][2] * v[j][2] + v[j][3] * v[j][3]);
        const float rstd = 1.f / sqrtf(wave_sum(s) * (1.f / D) + EPS);
        float* yo = dummy ? (float*)(a.ws + WS_XBC) + (size_t)row * D : a.out + O_Y + (size_t)row * D;
#pragma unroll
        for (int j = 0; j < 16; ++j) *(GAS f32x4*)(yo + 4 * (64 * j + lane)) = v[j] * rstd * wv[j];
    }
#undef FIN_LOAD
}

__global__ void __launch_bounds__(512, 2) mega_fwd(Args args) {
    extern __shared__ __attribute__((aligned(16))) unsigned char lds_raw[];
    LAS unsigned char* lds = (LAS unsigned char*)lds_raw;
    volatile LAS unsigned* MISC = (volatile LAS unsigned*)(lds + MISC_OFF);
    const int tid = threadIdx.x, bx = blockIdx.x, G = gridDim.x;
    for (int u = tid; u < (LDS_BYTES - LDSCTL_OFF) / 4; u += 512) ((LAS unsigned*)(lds + LDSCTL_OFF))[u] = 0u;
    __syncthreads();
    unsigned* ctl = (unsigned*)(args.ws + WS_CTL);
    XcdBarrier bar; bar.bar = ctl + CW_BAR; bar.x = 0; bar.st = nullptr;
    if (MK_N_LAUNCHES == 1) bar = xcd_barrier_post(ctl + CW_BAR, MISC + 8);
    const int lo = args.ph_lo, hi = args.ph_hi;
#ifdef ONLY_PHASE
#define IN(k) ((k) == ONLY_PHASE && lo <= (k) && (k) < hi)
#else
#define IN(k) (lo <= (k) && (k) < hi)
#endif
#define SEAM(k) do { if (IN(k) && IN((k) + 1)) xcd_barrier(bar); } while (0)

#define REPLOOP(N) for (int rep_ = 0; rep_ < (N); ++rep_, ((rep_ < (N)) ? xcd_barrier(bar) : (void)0))
    if (IN(0)) { REPLOOP(REP_P0) phase_prologue(args, lds, tid, bx, G, rep_ == 0); } SEAM(0);
#ifndef REP_P1
#define REP_P1 1
#endif
    if (IN(1)) { REPLOOP(REP_P1) phase_h(args, tid, bx, G, rep_ ? WS_ZM : WS_H); } SEAM(1);
    if (IN(2)) REPLOOP(REP_P2) {
        pg8::Gemm g{(const bf16*)(args.ws + WS_H), (const bf16*)(args.ws + WS_WIN), M, NIN, D}; pg8::StaticOrder S; S.init(M, NIN, G, bx);
        EpiIn E{args.ws, args.out, args.in[I_DTB]};
        pg8::gemm_phase<EpiIn, pg8::StaticOrder, true, true>(lds, g, S, E);
    } SEAM(2);
    if (IN(3)) { REPLOOP(REP_P3) phase_conv(args, tid, bx, G); } SEAM(3);
    if (IN(4)) {
        const int vcu = (G % 8 == 0) ? (bx % 8) * (G / 8) + bx / 8 : bx;
#ifndef NO_SSD
#ifndef SSD_HI
#define SSD_HI 16
#endif
        const bool ssd_bal = (G == 256); const int s_nc = vcu >= 128 ? SSD_HI : 16 - SSD_HI, s_b0 = vcu >= 128 ? 0 : SSD_HI;
        const int ssd_n = ssd_bal ? (s_nc > 0 ? 2 : 1) : (vcu < 2304 ? (2304 - vcu + G - 1) / G : 0);
        REPLOOP(REP_SSD) for (int ui = 0; ui < ssd_n; ++ui) { const int u = ssd_bal ? (ui == 0 ? vcu : 256 + s_b0 * 128 + (vcu & 127)) : vcu + G * ui; const int snc = ssd_bal ? s_nc : 1;
#ifdef PROBE_SSD_MODE
            if (rep_ > 0) { float* dummy = (float*)(args.ws + WS_XBC) + (size_t)u * 8192;
                if (u < 256) { const int b = u >> 7, hd = u & 127; ssd_unit<PROBE_SSD_MODE>(args, lds, tid, b * 128, 128, b * 8192, hd, nullptr, dummy, false); }
                else { const int us = u - 256, b = us >> 7, hd = us & 127; ssd_unit<PROBE_SSD_MODE>(args, lds, tid, 256 + b, 1, MP + b * 64, hd, args.in[I_SSSM] + (size_t)us * 8192, dummy, false); }
                continue; }
#endif
            if (u < 256) { const int b = u >> 7, hd = u & 127; ssd_unit<0>(args, lds, tid, b * 128, 128, b * 8192, hd, nullptr, args.out + O_SP + (size_t)u * 8192, false); }
            else { const int us = u - 256, b = us >> 7, hd = us & 127; ssd_unit<0>(args, lds, tid, 256 + b, snc, MP + b * 64, hd, args.in[I_SSSM] + (size_t)us * 8192, args.out + O_SS + (size_t)us * 8192, true); }
        }
#endif
        __syncthreads();
#ifndef NO_ATTN
        float lam;
        { float s1 = 0.f, s2 = 0.f; const int l = tid & 63; s1 = args.in[I_LQ1][l] * args.in[I_LK1][l]; s2 = args.in[I_LQ2][l] * args.in[I_LK2][l]; s1 = wave_sum(s1); s2 = wave_sum(s2); lam = expf(s1) - expf(s2) + 0.2f; lam = __builtin_bit_cast(float, __builtin_amdgcn_readfirstlane(__builtin_bit_cast(int, lam))); }
        int tid_a = threadIdx.x; asm volatile("" : "+v"(tid_a));
        const bf16* Qg = (const bf16*)(args.ws + WS_Q); bf16* Yag = (bf16*)(args.ws + WS_YA); float* park = (float*)(args.ws + WS_PARK) + (size_t)bx * 32768;
#define ATT_UP(it_, sub_, KB, VB, NT_, QR0, HKV) do { if ((it_) < 1024) { const int bh_ = (it_) >> 6, pr_ = (it_) & 63, b_ = bh_ >> 3, chunk_ = (sub_) ? 127 - pr_ : pr_; HKV = bh_ & 7; NT_ = chunk_ + 1; QR0 = b_ * 8192 + chunk_ * 64; \
            KB = (const bf16*)(args.ws + WS_KB) + (size_t)b_ * 8192 * 1024 + HKV * 128; VB = (const bf16*)(args.ws + WS_VB) + (size_t)b_ * 8192 * 1024 + HKV * 128; } \
        else { const int su_ = (it_) - 1024, b_ = su_ >> 3; HKV = su_ & 7; NT_ = 33; QR0 = MP + b_ * 64; KB = (const bf16*)(args.ws + WS_KS) + (size_t)b_ * 2112 * 1024 + HKV * 128; VB = (const bf16*)(args.ws + WS_VS) + (size_t)b_ * 2112 * 1024 + HKV * 128; } } while (0)
        REPLOOP(REP_ATT) { bf16x8 qx[4];
#pragma unroll
          for (int d0 = 0; d0 < 4; ++d0) qx[d0] = (bf16x8){0, 0, 0, 0, 0, 0, 0, 0};
          bool pre = false; int it = vcu, sub = 0;
          while (it < 1152) {
            const bf16 *Kb, *Vb, *Kbn = nullptr, *Vbn = nullptr; int NT, qrow0, hkv, NTn = 0, qrow0n = 0, hkvn = 0;
            ATT_UP(it, sub, Kb, Vb, NT, qrow0, hkv);
            int itn = it, subn = sub + 1; if (subn >= (it < 1024 ? 2 : 1)) { subn = 0; itn = it + G; }
            const bool hasn = itn < 1152;
            if (hasn) ATT_UP(itn, subn, Kbn, Vbn, NTn, qrow0n, hkvn);
            attn_unit<0>(Kb, Vb, NT, Qg + (size_t)qrow0 * D + hkv * 512, Yag + (size_t)qrow0 * D + hkv * 512, (const bf16*)(args.ws + WS_ZA) + (size_t)qrow0 * D + hkv * 512, args.in[I_ANW], park, lam, lds, tid_a,
                         Kbn, Vbn, hasn ? NTn : 0, Qg + (size_t)qrow0n * D + hkvn * 512, pre, qx);
            pre = hasn; it = itn; sub = subn;
          }
        }
#undef ATT_UP
#endif
        asm volatile("s_waitcnt vmcnt(0) lgkmcnt(0)" ::: "memory"); __syncthreads();
    } SEAM(4);
#ifndef REP_P5
#define REP_P5 1
#endif
    if (IN(5)) { REPLOOP(REP_P5) phase_norm(args, tid, bx, G, rep_ > 0); } SEAM(5);
    if (IN(6)) {
        pg8::Gemm2 g{(const bf16*)(args.ws + WS_YM), (const bf16*)(args.ws + WS_WPM), DI, (const bf16*)(args.ws + WS_YA), (const bf16*)(args.ws + WS_WPA), D}; pg8::SplitOrder S; S.init(G, bx);
        EpiG12 E{(const bf16*)(args.ws + WS_GM), (const bf16*)(args.ws + WS_GA), (bf16*)(args.ws + WS_MERGED), (float*)(args.ws + WS_TS)};
        pg8::gemm_phase2<EpiG12, pg8::SplitOrder>(lds, g, S, E);
    } SEAM(6);
    if (IN(7)) {
        if (USE_SPLIT && G == 256) { const float* TS = (const float*)(args.ws + WS_TS); bf16* MG = (bf16*)(args.ws + WS_MERGED) + (size_t)MP * D;
            for (int i = bx * 512 + tid; i < MS * D / 8; i += G * 512) { f32x4 t0 = {0.f, 0.f, 0.f, 0.f}, t1 = {0.f, 0.f, 0.f, 0.f};
#pragma unroll
                for (int sl = 0; sl < 4; ++sl) { t0 += *(const GAS f32x4*)(TS + (size_t)sl * MS * D + (size_t)i * 8); t1 += *(const GAS f32x4*)(TS + (size_t)sl * MS * D + (size_t)i * 8 + 4); }
                *(GAS u32x4*)(MG + (size_t)i * 8) = pack8(t0, t1); } }
    } SEAM(7);
    if (IN(8)) REPLOOP(REP_P7) {
        pg8::Gemm g{(const bf16*)(args.ws + WS_MERGED), (const bf16*)(args.ws + WS_WOUT), M, D, D}; pg8::SplitOrder S; S.init(G, bx);
        EpiOut E{(const float*)(args.ws + WS_MOD), (bf16*)(args.ws + WS_DLT), (float*)(args.ws + WS_PS)};
        pg8::gemm_phase<EpiOut, pg8::SplitOrder, true, true>(lds, g, S, E);
    } SEAM(8);
#ifndef REP_P9
#define REP_P9 1
#endif
    if (IN(9)) { for (int rep_ = REP_P9 - 1; rep_ >= 0; --rep_) { phase_final(args, tid, bx, G, rep_ > 0); if (rep_) xcd_barrier(bar); } }
#undef IN
#undef SEAM
}

extern "C" void kernel_launch(void* const* d_in, const int* in_sizes, int n_in, void* d_out, int out_size, void* d_ws, size_t ws_size, hipStream_t stream) {
    static int grid = 0;
    if (grid == 0) {
        if (n_in != 27 || out_size != 126382080 || ws_size < WS_END) { fprintf(stderr, "kernel_launch: unexpected problem: n_in %d out %d ws %zu (need %zu); nothing launched\n", n_in, out_size, ws_size, (size_t)WS_END); grid = -1; return; }
        int dev = 0, cus = 0, per_cu = 0;
        if (hipGetDevice(&dev) != hipSuccess || hipDeviceGetAttribute(&cus, hipDeviceAttributeMultiprocessorCount, dev) != hipSuccess) { grid = -1; return; }
        if (hipFuncSetAttribute((const void*)mega_fwd, hipFuncAttributeMaxDynamicSharedMemorySize, LDS_BYTES) != hipSuccess) { fprintf(stderr, "kernel_launch: hipFuncSetAttribute failed\n"); grid = -1; return; }
        if (hipOccupancyMaxActiveBlocksPerMultiprocessor(&per_cu, (const void*)mega_fwd, 512, LDS_BYTES) != hipSuccess || per_cu < 1) fprintf(stderr, "kernel_launch: occupancy query says %d\n", per_cu);
        (void)hipGetLastError();
        grid = cus;
    }
    if (grid < 0) return;
    if (hipMemsetAsync((char*)d_ws + WS_CTL, 0, CTL_ZERO_BYTES, stream) != hipSuccess) return;
    Args a{};
    for (int i = 0; i < 27; ++i) a.in[i] = (const float*)d_in[i];
    a.out = (float*)d_out; a.ws = (unsigned char*)d_ws;
    if (MK_N_LAUNCHES == 1) { a.ph_lo = 0; a.ph_hi = N_PHASES; hipLaunchKernelGGL(mega_fwd, dim3(grid), dim3(512), LDS_BYTES, stream, a); }
    else { for (int p = 0; p < N_PHASES; ++p) { a.ph_lo = p; a.ph_hi = p + 1; hipLaunchKernelGGL(mega_fwd, dim3(grid), dim3(512), LDS_BYTES, stream, a); } }
    const hipError_t le = hipPeekAtLastError();
    if (le != hipSuccess) fprintf(stderr, "kernel_launch: launch failed: %s\n", hipGetErrorName(le));
}
```

```cpp
#include <hip/hip_runtime.h>
#include <cstdio>
#include <cstdint>

#define GAS __attribute__((address_space(1)))
#define LAS __attribute__((address_space(3)))
typedef unsigned short bf16;
typedef short bf16x8 __attribute__((ext_vector_type(8)));
typedef float f32x4 __attribute__((ext_vector_type(4)));
typedef float f32x2 __attribute__((ext_vector_type(2)));
typedef float f32x16 __attribute__((ext_vector_type(16)));
typedef unsigned u32x4 __attribute__((ext_vector_type(4)));
typedef unsigned u32x2 __attribute__((ext_vector_type(2)));

#ifndef MK_N_LAUNCHES
#define MK_N_LAUNCHES 1
#endif
constexpr int N_PHASES = 10;
#ifndef USE_SPLIT
#define USE_SPLIT 1
#endif
#ifndef REP_P0
#define REP_P0 1
#endif
#ifndef REP_P2
#define REP_P2 1
#endif
#ifndef REP_P3
#define REP_P3 1
#endif
#ifndef REP_SSD
#define REP_SSD 1
#endif
#ifndef REP_ATT
#define REP_ATT 1
#endif
#ifndef REP_P6
#define REP_P6 1
#endif
#ifndef REP_P7
#define REP_P7 1
#endif

constexpr int D = 4096, MP = 16384, MS = 1024, M = MP + MS;
constexpr int NIN = 37120;
constexpr int DI = 8192, CD = 10240, NH = 128;
constexpr float EPS = 1e-6f;
constexpr float QSCALE = 0.125f * 1.4426950408889634f;

constexpr size_t O_Y = 0, O_KP = 71303168, O_VP = 88080384, O_CP = 104857600, O_SP = 104919040, O_KS = 107016192, O_VS = 108064768, O_CS = 109113344, O_SS = 109604864;

constexpr size_t MiB = 1u << 20;
constexpr size_t WS_CTL = 0, CTL_ZERO_BYTES = 2 * MiB;
constexpr size_t WS_MOD = 1 * MiB;
constexpr size_t WS_ROPE = 2 * MiB;
constexpr size_t WS_WPM = 4 * MiB, WS_WPA = 68 * MiB, WS_WOUT = 100 * MiB, WS_WIN = 132 * MiB;
constexpr size_t WS_YM = WS_WIN;
constexpr size_t WS_H = 422 * MiB;
constexpr size_t WS_YA = WS_H;
constexpr size_t WS_ZM = 558 * MiB;
constexpr size_t WS_MERGED = WS_ZM;
constexpr size_t WS_XBC = 830 * MiB;
constexpr size_t WS_PARK = WS_XBC;
constexpr size_t WS_T1 = WS_XBC;
constexpr size_t WS_Q = 1170 * MiB, WS_KB = 1306 * MiB, WS_VB = 1338 * MiB, WS_KS = 1370 * MiB, WS_VS = 1436 * MiB;
constexpr size_t WS_ZA = 1502 * MiB, WS_GM = 1638 * MiB, WS_GA = 1774 * MiB, WS_DT = 1910 * MiB;
constexpr size_t WS_XT = 1920 * MiB, WS_BN = 2192 * MiB, WS_BT = 2226 * MiB, WS_CN = 2260 * MiB, WS_END = 2294 * MiB;
constexpr size_t WS_TS = WS_Q;
constexpr size_t WS_DLT = WS_ZA;
constexpr size_t WS_PS = WS_KB;
constexpr int CW_BAR = 4096;

constexpr int RING_BYTES = 131072, LDS_BYTES = 147456, LDSCTL_OFF = LDS_BYTES - 512, MISC_OFF = LDSCTL_OFF + 320;

__device__ __forceinline__ unsigned cvt_pk_bf16(float lo, float hi) { unsigned r; asm volatile("v_cvt_pk_bf16_f32 %0, %1, %2" : "=v"(r) : "v"(lo), "v"(hi)); return r; }
__device__ __forceinline__ float bf_lo(unsigned u) { return __uint_as_float(u << 16); }
__device__ __forceinline__ float bf_hi(unsigned u) { return __uint_as_float(u & 0xffff0000u); }
__device__ __forceinline__ float bf2f(bf16 b) { return __uint_as_float((unsigned)b << 16); }
__device__ __forceinline__ bf16 f2bf(float f) { return (bf16)(cvt_pk_bf16(f, 0.f) & 0xffffu); }
__device__ __forceinline__ float silu_f(float x) { return x * __builtin_amdgcn_rcpf(1.f + __expf(-x)); }
__device__ __forceinline__ float sigm_f(float x) { return __builtin_amdgcn_rcpf(1.f + __expf(-x)); }
__device__ __forceinline__ float wave_sum(float v) {
#pragma unroll
    for (int o = 1; o < 64; o <<= 1) v += __shfl_xor(v, o);
    return v;
}
#define LBAR() do { asm volatile("s_waitcnt lgkmcnt(0)" ::: "memory"); __builtin_amdgcn_s_barrier(); asm volatile("" ::: "memory"); } while (0)

namespace pg8 {
#define PG8_LAS __attribute__((address_space(3)))
typedef unsigned short bf16_t;
constexpr int BM = 256, BK = 64, HALF = 128, HTB = HALF * BK * 2, STAGE_BYTES = 8 * HTB, NXCD = 8, WGM = 8;
__host__ __device__ __forceinline__ int lds_byte(int r, int c) { const int st = (r >> 4) * 2 + (c >> 5), rr = r & 15, cc = c & 31, ob = rr * 64 + cc * 2; return st * 1024 + (ob ^ (((ob >> 9) & 1) << 5)); }
__host__ __device__ __forceinline__ void stage_rc(int b, int& R, int& C) { const int st = b / 1024, sb = b % 1024, swz = sb ^ (((sb >> 9) & 1) << 5); R = (st >> 1) * 16 + swz / 64; C = (st & 1) * 32 + (swz % 64) / 2; }
__host__ __device__ __forceinline__ int perm32(int rho) { const int n = rho >> 4, i = rho & 15; return 8 * (i >> 2) + 4 * n + (i & 3); }
struct Unit { int pm, pn, kq, nq; };
struct Gemm { const bf16_t* A; const bf16_t* Bt; int M, N, K; };
struct StaticOrder {
    int nM, nN, nwg, G, c;
    __host__ __device__ void init(int M_, int N_, int G_, int c_) { nM = M_ / BM; nN = N_ / BM; nwg = nM * nN; G = G_; c = c_; }
    __host__ __device__ bool next(int i, Unit& u) const {
        const long L = (long)i * G + c; if (L >= nwg) return false;
        int wgid = (int)L; { const int q = nwg / NXCD, r = nwg % NXCD, xcd = wgid % NXCD, off = wgid / NXCD; wgid = (xcd < r ? xcd * (q + 1) : r * (q + 1) + (xcd - r) * q) + off; }
        const int nig = WGM * nN, gid = wgid / nig, fm = gid * WGM, gsz = (nM - fm) < WGM ? (nM - fm) : WGM;
        u.pm = fm + ((wgid % nig) % gsz); u.pn = (wgid % nig) / gsz; u.kq = 0; u.nq = 1; return true;
    }
    __device__ __forceinline__ void a_ready(const Unit&) const {}
    __device__ __forceinline__ void done(const Unit&) const {}
};
struct SplitOrder {
    StaticOrder sp, sf; bool split; int c;
    __host__ __device__ void init(int G_, int c_) { split = USE_SPLIT && (G_ == 256); c = c_; sp.init(16384, 4096, G_, c_); sf.init(17408, 4096, G_, c_); }
    __host__ __device__ bool next(int i, Unit& u) const {
        if (!split) return sf.next(i, u);
        if (i == 0) { const int su = c >> 2; u.pm = 64 + (su >> 4); u.pn = su & 15; u.kq = c & 3; u.nq = 4; return true; }
        return sp.next(i - 1, u);
    }
    __device__ __forceinline__ void a_ready(const Unit&) const {}
    __device__ __forceinline__ void done(const Unit&) const {}
};
template <class Epi, class Sched, bool ALIGN_EPI = false, bool SP2 = false>
__device__ __forceinline__ void gemm_phase(PG8_LAS unsigned char* lds, const Gemm g, const Sched& S, const Epi& E) {
    const int tid = threadIdx.x, wid = __builtin_amdgcn_readfirstlane(tid >> 6), lane = tid & 63, wr = wid >> 2, wc = wid & 3, fr = lane & 15, fq = lane >> 4;
    const int K = g.K, nt = K / BK;
    unsigned voffA[2], voffB[2];
#pragma unroll
    for (int i = 0; i < 2; ++i) { int R, C; stage_rc(tid * 16 + i * 8192, R, C); const int Rb = Epi::PERM ? ((R & ~31) + perm32(R & 31)) : R;
        voffA[i] = (unsigned)(R * K + C) * 2u; voffB[i] = (unsigned)(Rb * K + C) * 2u; }
    const size_t kstep = (size_t)(BK * 2);
    const size_t hstep = (size_t)HALF * K * 2;
    const size_t tstep = 2 * hstep;
    const unsigned ldsw = (unsigned)wid * 1024u;
    const int aoff = lds_byte(wr * 64 + fr, fq * 8), boff = lds_byte(wc * 32 + fr, fq * 8);
#define PG8_SA(b, h) (((b) * 2 + (h)) * HTB)
#define PG8_SB(b, h) ((4 + (b) * 2 + (h)) * HTB)
#define PG8_STAGE(bufoff, gbase, voff) do { _Pragma("unroll") for (int _i = 0; _i < 2; ++_i) \
        __builtin_amdgcn_global_load_lds((const unsigned*)((const char*)(gbase) + (voff)[_i]), (PG8_LAS unsigned*)(lds + (bufoff) + ldsw + _i * 8192), 16, 0, 0); } while (0)
#define PG8_LDA(dst, b, h) do { _Pragma("unroll") for (int m = 0; m < 4; ++m) _Pragma("unroll") for (int k = 0; k < 2; ++k) dst[m][k] = *(const PG8_LAS bf16x8*)(lds + PG8_SA(b, h) + aoff + m * 2048 + k * 1024); } while (0)
#define PG8_LDB(dst, b, h) do { _Pragma("unroll") for (int n = 0; n < 2; ++n) _Pragma("unroll") for (int k = 0; k < 2; ++k) dst[n][k] = *(const PG8_LAS bf16x8*)(lds + PG8_SB(b, h) + boff + n * 2048 + k * 1024); } while (0)
#define PG8_MMA(ai, bj, At, Bt) do { __builtin_amdgcn_s_setprio(1); _Pragma("unroll") for (int m = 0; m < 4; ++m) _Pragma("unroll") for (int n = 0; n < 2; ++n) _Pragma("unroll") for (int k = 0; k < 2; ++k) \
        acc[ai][bj][m][n] = __builtin_amdgcn_mfma_f32_16x16x32_bf16(Bt[n][k], At[m][k], acc[ai][bj][m][n], 0, 0, 0); __builtin_amdgcn_s_setprio(0); } while (0)
#define PG8_WAIT_V(n) asm volatile("s_waitcnt vmcnt(" #n ")" ::: "memory")
#define PG8_WAIT_L(n) asm volatile("s_waitcnt lgkmcnt(" #n ")" ::: "memory")
#define PG8_BAR __builtin_amdgcn_s_barrier()
#define PG8_SCHED __builtin_amdgcn_sched_barrier(0)
    Unit cur, nxt; int ui = 0;
    if (!S.next(0, cur)) return;
    f32x4 acc[2][2][4][2];
#pragma unroll
    for (int a = 0; a < 2; ++a)
#pragma unroll
        for (int b = 0; b < 2; ++b)
#pragma unroll
            for (int m = 0; m < 4; ++m)
#pragma unroll
                for (int n = 0; n < 2; ++n) acc[a][b][m][n] = (f32x4){0.f, 0.f, 0.f, 0.f};
    bf16x8 At[4][2], B0[2][2], B1[2][2];
    int ntc = nt / cur.nq;
    const char* cA = (const char*)g.A + (size_t)cur.pm * tstep + (size_t)(cur.kq * ntc) * kstep; const char* cB = (const char*)g.Bt + (size_t)cur.pn * tstep + (size_t)(cur.kq * ntc) * kstep;
    S.a_ready(cur);
    if constexpr (SP2) {
        PG8_STAGE(PG8_SB(0, 0), cB, voffB); PG8_STAGE(PG8_SB(0, 1), cB + hstep, voffB); PG8_STAGE(PG8_SA(0, 0), cA, voffA); PG8_STAGE(PG8_SA(0, 1), cA + hstep, voffA);
        if (wr == 1) PG8_BAR;
        PG8_WAIT_V(2); PG8_BAR;
        PG8_STAGE(PG8_SB(1, 0), cB + kstep, voffB); PG8_STAGE(PG8_SA(1, 0), cA + kstep, voffA); PG8_STAGE(PG8_SB(1, 1), cB + hstep + kstep, voffB);
        PG8_WAIT_V(6); PG8_BAR;
    } else {
        PG8_STAGE(PG8_SB(0, 0), cB, voffB); PG8_STAGE(PG8_SA(0, 0), cA, voffA); PG8_STAGE(PG8_SB(0, 1), cB + hstep, voffB); PG8_STAGE(PG8_SA(0, 1), cA + hstep, voffA);
        if (wr == 1) PG8_BAR;
        PG8_WAIT_V(4); PG8_BAR;
        PG8_STAGE(PG8_SB(1, 0), cB + kstep, voffB); PG8_STAGE(PG8_SA(1, 0), cA + kstep, voffA); PG8_STAGE(PG8_SB(1, 1), cB + hstep + kstep, voffB);
        PG8_WAIT_V(6); PG8_BAR;
    }
    for (;;) {
        const bool has_next = S.next(ui + 1, nxt);
        const int ntn = has_next ? nt / nxt.nq : ntc;
        const char* nA = has_next ? (const char*)g.A + (size_t)nxt.pm * tstep + (size_t)(nxt.kq * ntn) * kstep : cA; const char* nB = has_next ? (const char*)g.Bt + (size_t)nxt.pn * tstep + (size_t)(nxt.kq * ntn) * kstep : cB;
        for (int t = 0; t < ntc; t += 2) {
            const bool last = (t == ntc - 2);
            const char* a1 = cA + (size_t)(t + 1) * kstep;
            const char* a2 = last ? nA : cA + (size_t)(t + 2) * kstep; const char* b2 = last ? nB : cB + (size_t)(t + 2) * kstep;
            const char* a3 = a2 + kstep; const char* b3 = b2 + kstep;
            if (last && has_next) S.a_ready(nxt);
            if constexpr (SP2) {
            PG8_LDB(B0, 0, 0); PG8_LDB(B1, 0, 1); PG8_SCHED; PG8_LDA(At, 0, 0); PG8_STAGE(PG8_SA(1, 1), a1 + hstep, voffA);
            PG8_WAIT_V(8); PG8_WAIT_L(0); PG8_BAR; PG8_MMA(0, 0, At, B0); PG8_MMA(0, 1, At, B1); PG8_BAR; PG8_SCHED;
            PG8_LDA(At, 0, 1); PG8_STAGE(PG8_SB(0, 0), b2, voffB); PG8_STAGE(PG8_SB(0, 1), b2 + hstep, voffB); PG8_STAGE(PG8_SA(0, 0), a2, voffA);
            PG8_WAIT_V(8); PG8_WAIT_L(0); PG8_BAR; PG8_MMA(1, 0, At, B0); PG8_MMA(1, 1, At, B1); PG8_BAR; PG8_SCHED;
            PG8_LDB(B0, 1, 0); PG8_LDB(B1, 1, 1); PG8_SCHED; PG8_LDA(At, 1, 0); PG8_STAGE(PG8_SA(0, 1), a2 + hstep, voffA);
            PG8_WAIT_V(8); PG8_WAIT_L(0); PG8_BAR; PG8_MMA(0, 0, At, B0); PG8_MMA(0, 1, At, B1); PG8_BAR; PG8_SCHED;
            PG8_LDA(At, 1, 1); PG8_STAGE(PG8_SB(1, 0), b3, voffB); PG8_STAGE(PG8_SB(1, 1), b3 + hstep, voffB); PG8_STAGE(PG8_SA(1, 0), a3, voffA);
            PG8_WAIT_V(8); PG8_WAIT_L(0); PG8_BAR; PG8_MMA(1, 0, At, B0); PG8_MMA(1, 1, At, B1); PG8_BAR; PG8_SCHED;
            } else {
            PG8_LDB(B0, 0, 0); PG8_SCHED; PG8_LDA(At, 0, 0); PG8_STAGE(PG8_SA(1, 1), a1 + hstep, voffA);
            PG8_WAIT_L(8); PG8_BAR; PG8_WAIT_L(0); PG8_MMA(0, 0, At, B0); PG8_BAR; PG8_SCHED;
            PG8_LDB(B1, 0, 1); PG8_STAGE(PG8_SB(0, 0), b2, voffB);
            PG8_BAR; PG8_WAIT_L(0); PG8_MMA(0, 1, At, B1); PG8_BAR;
            PG8_LDA(At, 0, 1); PG8_STAGE(PG8_SA(0, 0), a2, voffA);
            PG8_BAR; PG8_WAIT_L(0); PG8_MMA(1, 0, At, B0); PG8_BAR; PG8_SCHED;
            PG8_STAGE(PG8_SB(0, 1), b2 + hstep, voffB);
            PG8_WAIT_V(6); PG8_BAR; PG8_MMA(1, 1, At, B1); PG8_BAR;
            PG8_LDB(B0, 1, 0); PG8_SCHED; PG8_LDA(At, 1, 0); PG8_STAGE(PG8_SA(0, 1), a2 + hstep, voffA);
            PG8_WAIT_L(8); PG8_BAR; PG8_WAIT_L(0); PG8_MMA(0, 0, At, B0); PG8_BAR; PG8_SCHED;
            PG8_LDB(B1, 1, 1); PG8_STAGE(PG8_SB(1, 0), b3, voffB);
            PG8_BAR; PG8_WAIT_L(0); PG8_MMA(0, 1, At, B1); PG8_BAR;
            PG8_LDA(At, 1, 1); PG8_STAGE(PG8_SA(1, 0), a3, voffA);
            PG8_BAR; PG8_WAIT_L(0); PG8_MMA(1, 0, At, B0); PG8_BAR; PG8_SCHED;
            PG8_STAGE(PG8_SB(1, 1), b3 + hstep, voffB);
            PG8_WAIT_V(6); PG8_BAR; PG8_MMA(1, 1, At, B1); PG8_BAR;
            }
        }
        if constexpr (ALIGN_EPI) { if (wr == 0) PG8_BAR; }
        E(acc, cur, wr, wc, fr, fq); S.done(cur);
        if (!has_next) break;
#pragma unroll
        for (int a = 0; a < 2; ++a)
#pragma unroll
            for (int b = 0; b < 2; ++b)
#pragma unroll
                for (int m = 0; m < 4; ++m)
#pragma unroll
                    for (int n = 0; n < 2; ++n) acc[a][b][m][n] = (f32x4){0.f, 0.f, 0.f, 0.f};
        cur = nxt; cA = nA; cB = nB; ntc = ntn; ++ui;
        if constexpr (ALIGN_EPI) { if (wr == 1) PG8_BAR; }
    }
    PG8_WAIT_V(0);
    if constexpr (!ALIGN_EPI) { if (wr == 0) PG8_BAR; }
    PG8_BAR;
#undef PG8_SA
#undef PG8_SB
#undef PG8_STAGE
#undef PG8_LDA
#undef PG8_LDB
#undef PG8_MMA
#undef PG8_WAIT_V
#undef PG8_WAIT_L
#undef PG8_BAR
#undef PG8_SCHED
}

struct Gemm2 { const bf16_t* A0; const bf16_t* B0; int K0; const bf16_t* A1; const bf16_t* B1; int K1; };
template <class Epi, class Sched>
__device__ __forceinline__ void gemm_phase2(PG8_LAS unsigned char* lds, const Gemm2 g, const Sched& S, const Epi& E) {
    const int tid = threadIdx.x, wid = __builtin_amdgcn_readfirstlane(tid >> 6), lane = tid & 63, wr = wid >> 2, wc = wid & 3, fr = lane & 15, fq = lane >> 4;
    unsigned r2A[2], r2B[2], c2[2];
#pragma unroll
    for (int i = 0; i < 2; ++i) { int R, C; stage_rc(tid * 16 + i * 8192, R, C); const int Rb = (R & ~31) + perm32(R & 31); r2A[i] = (unsigned)R * 2u; r2B[i] = (unsigned)Rb * 2u; c2[i] = (unsigned)C * 2u; }
    const size_t kstep = (size_t)(BK * 2);
    const unsigned ldsw = (unsigned)wid * 1024u;
    const int aoff = lds_byte(wr * 64 + fr, fq * 8), boff = lds_byte(wc * 32 + fr, fq * 8);
#define PG8_SA(b, h) (((b) * 2 + (h)) * HTB)
#define PG8_SB(b, h) ((4 + (b) * 2 + (h)) * HTB)
#define PG8_STAGE2(bufoff, gbase, v0, v1) do { \
        __builtin_amdgcn_global_load_lds((const unsigned*)((const char*)(gbase) + (v0)), (PG8_LAS unsigned*)(lds + (bufoff) + ldsw), 16, 0, 0); \
        __builtin_amdgcn_global_load_lds((const unsigned*)((const char*)(gbase) + (v1)), (PG8_LAS unsigned*)(lds + (bufoff) + ldsw + 8192), 16, 0, 0); } while (0)
#define PG8_LDA(dst, b, h) do { _Pragma("unroll") for (int m = 0; m < 4; ++m) _Pragma("unroll") for (int k = 0; k < 2; ++k) dst[m][k] = *(const PG8_LAS bf16x8*)(lds + PG8_SA(b, h) + aoff + m * 2048 + k * 1024); } while (0)
#define PG8_LDB(dst, b, h) do { _Pragma("unroll") for (int n = 0; n < 2; ++n) _Pragma("unroll") for (int k = 0; k < 2; ++k) dst[n][k] = *(const PG8_LAS bf16x8*)(lds + PG8_SB(b, h) + boff + n * 2048 + k * 1024); } while (0)
#define PG8_MMA(ai, bj, At, Bt) do { __builtin_amdgcn_s_setprio(1); _Pragma("unroll") for (int m = 0; m < 4; ++m) _Pragma("unroll") for (int n = 0; n < 2; ++n) _Pragma("unroll") for (int k = 0; k < 2; ++k) \
        acc[ai][bj][m][n] = __builtin_amdgcn_mfma_f32_16x16x32_bf16(Bt[n][k], At[m][k], acc[ai][bj][m][n], 0, 0, 0); __builtin_amdgcn_s_setprio(0); } while (0)
#define PG8_WAIT_V(n) asm volatile("s_waitcnt vmcnt(" #n ")" ::: "memory")
#define PG8_WAIT_L(n) asm volatile("s_waitcnt lgkmcnt(" #n ")" ::: "memory")
#define PG8_BAR __builtin_amdgcn_s_barrier()
#define PG8_SCHED __builtin_amdgcn_sched_barrier(0)
#define PG8_SEG(U, SEG, PA, PB, NT, HS, VA0, VA1, VB0, VB1) do { const int K_ = (SEG) ? g.K1 : g.K0; NT = (K_ / BK) / (U).nq; HS = (size_t)HALF * K_ * 2; \
        PA = (const char*)((SEG) ? g.A1 : g.A0) + (size_t)(U).pm * 2 * HS + (size_t)((U).kq * NT) * kstep; PB = (const char*)((SEG) ? g.B1 : g.B0) + (size_t)(U).pn * 2 * HS + (size_t)((U).kq * NT) * kstep; \
        VA0 = r2A[0] * (unsigned)K_ + c2[0]; VA1 = r2A[1] * (unsigned)K_ + c2[1]; VB0 = r2B[0] * (unsigned)K_ + c2[0]; VB1 = r2B[1] * (unsigned)K_ + c2[1]; } while (0)
    Unit cur, nxt; int ui = 0, cseg = 0;
    if (!S.next(0, cur)) return;
    f32x4 acc[2][2][4][2];
#pragma unroll
    for (int a = 0; a < 2; ++a)
#pragma unroll
        for (int b = 0; b < 2; ++b)
#pragma unroll
            for (int m = 0; m < 4; ++m)
#pragma unroll
                for (int n = 0; n < 2; ++n) acc[a][b][m][n] = (f32x4){0.f, 0.f, 0.f, 0.f};
    bf16x8 At[4][2], B0[2][2], B1[2][2];
    const char *cA, *cB, *nA, *nB; int ntc, ntn; size_t hsc, hsn; unsigned vAc0, vAc1, vBc0, vBc1, vAn0, vAn1, vBn0, vBn1;
    PG8_SEG(cur, 0, cA, cB, ntc, hsc, vAc0, vAc1, vBc0, vBc1);
    PG8_STAGE2(PG8_SB(0, 0), cB, vBc0, vBc1); PG8_STAGE2(PG8_SB(0, 1), cB + hsc, vBc0, vBc1); PG8_STAGE2(PG8_SA(0, 0), cA, vAc0, vAc1); PG8_STAGE2(PG8_SA(0, 1), cA + hsc, vAc0, vAc1);
    if (wr == 1) PG8_BAR;
    PG8_WAIT_V(2); PG8_BAR;
    PG8_STAGE2(PG8_SB(1, 0), cB + kstep, vBc0, vBc1); PG8_STAGE2(PG8_SA(1, 0), cA + kstep, vAc0, vAc1); PG8_STAGE2(PG8_SB(1, 1), cB + hsc + kstep, vBc0, vBc1);
    PG8_WAIT_V(6); PG8_BAR;
    for (;;) {
        bool has_next;
        if (cseg == 0) { has_next = true; nxt = cur; PG8_SEG(cur, 1, nA, nB, ntn, hsn, vAn0, vAn1, vBn0, vBn1); }
        else { has_next = S.next(ui + 1, nxt); if (has_next) PG8_SEG(nxt, 0, nA, nB, ntn, hsn, vAn0, vAn1, vBn0, vBn1); else { nA = cA; nB = cB; ntn = ntc; hsn = hsc; vAn0 = vAc0; vAn1 = vAc1; vBn0 = vBc0; vBn1 = vBc1; } }
        for (int t = 0; t < ntc; t += 2) {
            const bool last = (t == ntc - 2);
            const char* a1 = cA + (size_t)(t + 1) * kstep;
            const char* a2 = last ? nA : cA + (size_t)(t + 2) * kstep; const char* b2 = last ? nB : cB + (size_t)(t + 2) * kstep;
            const char* a3 = a2 + kstep; const char* b3 = b2 + kstep;
            const size_t h2 = last ? hsn : hsc; const unsigned wA0 = last ? vAn0 : vAc0, wA1 = last ? vAn1 : vAc1, wB0 = last ? vBn0 : vBc0, wB1 = last ? vBn1 : vBc1;
            PG8_LDB(B0, 0, 0); PG8_LDB(B1, 0, 1); PG8_SCHED; PG8_LDA(At, 0, 0); PG8_STAGE2(PG8_SA(1, 1), a1 + hsc, vAc0, vAc1);
            PG8_WAIT_V(8); PG8_WAIT_L(0); PG8_BAR; PG8_MMA(0, 0, At, B0); PG8_MMA(0, 1, At, B1); PG8_BAR; PG8_SCHED;
            PG8_LDA(At, 0, 1); PG8_STAGE2(PG8_SB(0, 0), b2, wB0, wB1); PG8_STAGE2(PG8_SB(0, 1), b2 + h2, wB0, wB1); PG8_STAGE2(PG8_SA(0, 0), a2, wA0, wA1);
            PG8_WAIT_V(8); PG8_WAIT_L(0); PG8_BAR; PG8_MMA(1, 0, At, B0); PG8_MMA(1, 1, At, B1); PG8_BAR; PG8_SCHED;
            PG8_LDB(B0, 1, 0); PG8_LDB(B1, 1, 1); PG8_SCHED; PG8_LDA(At, 1, 0); PG8_STAGE2(PG8_SA(0, 1), a2 + h2, wA0, wA1);
            PG8_WAIT_V(8); PG8_WAIT_L(0); PG8_BAR; PG8_MMA(0, 0, At, B0); PG8_MMA(0, 1, At, B1); PG8_BAR; PG8_SCHED;
            PG8_LDA(At, 1, 1); PG8_STAGE2(PG8_SB(1, 0), b3, wB0, wB1); PG8_STAGE2(PG8_SB(1, 1), b3 + h2, wB0, wB1); PG8_STAGE2(PG8_SA(1, 0), a3, wA0, wA1);
            PG8_WAIT_V(8); PG8_WAIT_L(0); PG8_BAR; PG8_MMA(1, 0, At, B0); PG8_MMA(1, 1, At, B1); PG8_BAR; PG8_SCHED;
        }
        if (wr == 0) PG8_BAR;
        if (cseg == 0) E.mid(acc, cur, wr, wc, fr, fq); else E(acc, cur, wr, wc, fr, fq);
        if (!has_next) break;
        if (cseg == 1) {
#pragma unroll
            for (int a = 0; a < 2; ++a)
#pragma unroll
                for (int b = 0; b < 2; ++b)
#pragma unroll
                    for (int m = 0; m < 4; ++m)
#pragma unroll
                        for (int n = 0; n < 2; ++n) acc[a][b][m][n] = (f32x4){0.f, 0.f, 0.f, 0.f};
            cur = nxt; ++ui; }
        cseg ^= 1; cA = nA; cB = nB; ntc = ntn; hsc = hsn; vAc0 = vAn0; vAc1 = vAn1; vBc0 = vBn0; vBc1 = vBn1;
        if (wr == 1) PG8_BAR;
    }
    PG8_WAIT_V(0);
    PG8_BAR;
#undef PG8_SA
#undef PG8_SB
#undef PG8_STAGE2
#undef PG8_LDA
#undef PG8_LDB
#undef PG8_MMA
#undef PG8_WAIT_V
#undef PG8_WAIT_L
#undef PG8_BAR
#undef PG8_SCHED
#undef PG8_SEG
}
}

#define EPI_FOR3 _Pragma("unroll") for (int ai = 0; ai < 2; ++ai) _Pragma("unroll") for (int m = 0; m < 4; ++m) _Pragma("unroll") for (int bj = 0; bj < 2; ++bj)

__device__ __forceinline__ u32x4 pack8(f32x4 v0, f32x4 v1) { u32x4 w; w.x = cvt_pk_bf16(v0[0], v0[1]); w.y = cvt_pk_bf16(v0[2], v0[3]); w.z = cvt_pk_bf16(v1[0], v1[1]); w.w = cvt_pk_bf16(v1[2], v1[3]); return w; }

struct EpiIn {
    static constexpr bool PERM = true, AFTER_DRAIN = false;
    unsigned char* ws; float* out; const float* dt_bias;
    template <int ACT> __device__ __forceinline__ void store_act(const f32x4 (&acc)[2][2][4][2], bf16* base, int ld, int rbase, int col0) const {
        EPI_FOR3 { f32x4 v0 = acc[ai][bj][m][0], v1 = acc[ai][bj][m][1];
            if (ACT == 1) { _Pragma("unroll") for (int e = 0; e < 4; ++e) { v0[e] = silu_f(v0[e]); v1[e] = silu_f(v1[e]); } }
            if (ACT == 2) { _Pragma("unroll") for (int e = 0; e < 4; ++e) { v0[e] = sigm_f(v0[e]); v1[e] = sigm_f(v1[e]); } }
            *(GAS u32x4*)(base + (size_t)(rbase + ai * 128 + m * 16) * ld + col0 + bj * 128) = pack8(v0, v1); }
    }
    __device__ __forceinline__ void operator()(const f32x4 (&acc)[2][2][4][2], const pg8::Unit& u, int wr, int wc, int fr, int fq) const {
        const int pn = u.pn, rbase = u.pm * 256 + wr * 64 + fr, cl = wc * 32 + 8 * fq;
        if (pn < 32) { store_act<1>(acc, (bf16*)(ws + WS_ZM), DI, rbase, pn * 256 + cl); }
        else if (pn < 72) {
            const int c0 = (pn - 32) * 256 + cl;
            store_act<0>(acc, (bf16*)(ws + WS_XBC), CD, rbase, c0);
            if (fr >= 13 && (u.pm >= 64 || ((u.pm & 31) == 31 && wr == 1))) {
#pragma unroll
                for (int ai = 0; ai < 2; ++ai) { if (u.pm < 64 && ai == 0) continue;
                    const int row = rbase + ai * 128 + 48; float* dst;
                    if (row < MP) dst = out + O_CP + (size_t)((row >> 13) * 3 + ((row & 8191) - 8189)) * CD; else dst = out + O_CS + (size_t)(((row - MP) >> 6) * 3 + ((row & 63) - 61)) * CD;
#pragma unroll
                    for (int bj = 0; bj < 2; ++bj) { *(GAS f32x4*)(dst + c0 + bj * 128) = acc[ai][bj][3][0]; *(GAS f32x4*)(dst + c0 + bj * 128 + 4) = acc[ai][bj][3][1]; } }
            }
        }
        else if (pn < 96) {
            const int kind = pn < 88 ? 0 : (pn < 92 ? 1 : 2);
            const int c0 = (pn - (kind == 0 ? 72 : (kind == 1 ? 88 : 92))) * 256 + cl;
            const float* rope = (const float*)(ws + WS_ROPE);
            EPI_FOR3 { f32x4 v0 = acc[ai][bj][m][0], v1 = acc[ai][bj][m][1];
                const int row = rbase + ai * 128 + m * 16;
                if (kind < 2 && (wc & 1) == 0) {
                    f32x4 p0, p1;
#pragma unroll
                    for (int e = 0; e < 4; ++e) { p0[e] = __shfl_xor(v0[e], 16); p1[e] = __shfl_xor(v1[e], 16); }
                    if (fq < 2) {
                        const int pos = row < MP ? (row & 8191) : 2048 + (row & 63);
                        const f32x4 c0v = *(const GAS f32x4*)(rope + pos * 16), c1v = *(const GAS f32x4*)(rope + pos * 16 + 4), s0v = *(const GAS f32x4*)(rope + pos * 16 + 8), s1v = *(const GAS f32x4*)(rope + pos * 16 + 12);
                        const float sg = fq == 0 ? -1.f : 1.f;
                        v0 = v0 * c0v + sg * (p0 * s0v); v1 = v1 * c1v + sg * (p1 * s1v);
                    }
                }
                if (kind == 0) { v0 = v0 * QSCALE; v1 = v1 * QSCALE; *(GAS u32x4*)((bf16*)(ws + WS_Q) + (size_t)row * D + c0 + bj * 128) = pack8(v0, v1); }
                else {
                    float* fo; bf16* bo;
                    if (row < MP) { fo = out + (kind == 1 ? O_KP : O_VP) + (size_t)row * 1024; bo = (bf16*)(ws + (kind == 1 ? WS_KB : WS_VB)) + (size_t)row * 1024; }
                    else { const int rs = row - MP; fo = out + (kind == 1 ? O_KS : O_VS) + (size_t)rs * 1024; bo = (bf16*)(ws + (kind == 1 ? WS_KS : WS_VS)) + (size_t)((rs >> 6) * 2112 + 2048 + (rs & 63)) * 1024; }
                    *(GAS f32x4*)(fo + c0 + bj * 128) = v0; *(GAS f32x4*)(fo + c0 + bj * 128 + 4) = v1;
                    *(GAS u32x4*)(bo + c0 + bj * 128) = pack8(v0, v1);
                }
            }
        }
        else if (pn < 112) { store_act<1>(acc, (bf16*)(ws + WS_ZA), D, rbase, (pn - 96) * 256 + cl); }
        else if (pn < 128) { store_act<2>(acc, (bf16*)(ws + WS_GM), D, rbase, (pn - 112) * 256 + cl); }
        else if (pn < 144) { store_act<2>(acc, (bf16*)(ws + WS_GA), D, rbase, (pn - 128) * 256 + cl); }
        else {
            float* DT = (float*)(ws + WS_DT);
            const f32x4 b0 = *(const GAS f32x4*)(dt_bias + cl), b1 = *(const GAS f32x4*)(dt_bias + cl + 4);
#pragma unroll
            for (int ai = 0; ai < 2; ++ai)
#pragma unroll
                for (int m = 0; m < 4; ++m) { f32x4 v0 = acc[ai][0][m][0] + b0, v1 = acc[ai][0][m][1] + b1;
#pragma unroll
                    for (int e = 0; e < 4; ++e) { v0[e] = v0[e] > 20.f ? v0[e] : log1pf(expf(v0[e])); v1[e] = v1[e] > 20.f ? v1[e] : log1pf(expf(v1[e])); }
                    float* dst = DT + (size_t)(rbase + ai * 128 + m * 16) * NH + cl; *(GAS f32x4*)dst = v0; *(GAS f32x4*)(dst + 4) = v1; }
        }
    }
};
__device__ __forceinline__ void atomic_add8(float* p, f32x4 v0, f32x4 v1) {
#pragma unroll
    for (int e = 0; e < 4; ++e) { unsafeAtomicAdd(p + e, v0[e]); unsafeAtomicAdd(p + 4 + e, v1[e]); }
}
struct EpiG1 {
    static constexpr bool PERM = true, AFTER_DRAIN = false;
    const bf16* GM; float* T1; float* TS;
    __device__ __forceinline__ void operator()(const f32x4 (&acc)[2][2][4][2], const pg8::Unit& u, int wr, int wc, int fr, int fq) const {
        const int rbase = u.pm * 256 + wr * 64 + fr, c0 = u.pn * 256 + wc * 32 + 8 * fq;
        u32x4 gv[2][4][2];
        EPI_FOR3 gv[ai][m][bj] = *(const GAS u32x4*)(GM + (size_t)(rbase + ai * 128 + m * 16) * D + c0 + bj * 128);
        float* dst = (u.nq > 1) ? TS + (size_t)u.kq * MS * D - (size_t)MP * D : T1;
        EPI_FOR3 { const size_t off = (size_t)(rbase + ai * 128 + m * 16) * D + c0 + bj * 128; const u32x4 g = gv[ai][m][bj];
            f32x4 v0 = acc[ai][bj][m][0], v1 = acc[ai][bj][m][1];
            v0[0] *= bf_lo(g.x); v0[1] *= bf_hi(g.x); v0[2] *= bf_lo(g.y); v0[3] *= bf_hi(g.y); v1[0] *= bf_lo(g.z); v1[1] *= bf_hi(g.z); v1[2] *= bf_lo(g.w); v1[3] *= bf_hi(g.w);
            *(GAS f32x4*)(dst + off) = v0; *(GAS f32x4*)(dst + off + 4) = v1; }
    }
};
struct EpiG2 {
    static constexpr bool PERM = true, AFTER_DRAIN = false;
    const bf16* GA; const float* T1; bf16* MG; float* TS;
    __device__ __forceinline__ void operator()(const f32x4 (&acc)[2][2][4][2], const pg8::Unit& u, int wr, int wc, int fr, int fq) const {
        const int rbase = u.pm * 256 + wr * 64 + fr, c0 = u.pn * 256 + wc * 32 + 8 * fq;
        const bool sp = u.nq > 1; float* ts = TS + (size_t)(4 + u.kq) * MS * D - (size_t)MP * D;
#pragma unroll
        for (int am = 0; am < 4; ++am) { const int ai = am >> 1, mh = (am & 1) * 2; u32x4 gv[4][2]; f32x4 t0[4][2], t1[4][2];
#pragma unroll
            for (int m = mh; m < mh + 2; ++m)
#pragma unroll
                for (int bj = 0; bj < 2; ++bj) { const size_t off = (size_t)(rbase + ai * 128 + m * 16) * D + c0 + bj * 128; gv[m][bj] = *(const GAS u32x4*)(GA + off);
                    if (!sp) { t0[m][bj] = *(const GAS f32x4*)(T1 + off); t1[m][bj] = *(const GAS f32x4*)(T1 + off + 4); } else { t0[m][bj] = (f32x4){0.f, 0.f, 0.f, 0.f}; t1[m][bj] = (f32x4){0.f, 0.f, 0.f, 0.f}; } }
#pragma unroll
            for (int m = mh; m < mh + 2; ++m)
#pragma unroll
                for (int bj = 0; bj < 2; ++bj) { const size_t off = (size_t)(rbase + ai * 128 + m * 16) * D + c0 + bj * 128; const u32x4 g = gv[m][bj];
                    f32x4 v0 = acc[ai][bj][m][0], v1 = acc[ai][bj][m][1];
                    v0[0] = t0[m][bj][0] + v0[0] * bf_lo(g.x); v0[1] = t0[m][bj][1] + v0[1] * bf_hi(g.x); v0[2] = t0[m][bj][2] + v0[2] * bf_lo(g.y); v0[3] = t0[m][bj][3] + v0[3] * bf_hi(g.y);
                    v1[0] = t1[m][bj][0] + v1[0] * bf_lo(g.z); v1[1] = t1[m][bj][1] + v1[1] * bf_hi(g.z); v1[2] = t1[m][bj][2] + v1[2] * bf_lo(g.w); v1[3] = t1[m][bj][3] + v1[3] * bf_hi(g.w);
                    if (sp) { *(GAS f32x4*)(ts + off) = v0; *(GAS f32x4*)(ts + off + 4) = v1; } else *(GAS u32x4*)(MG + off) = pack8(v0, v1); } }
    }
};
struct EpiG12 {
    static constexpr bool PERM = true, AFTER_DRAIN = false;
    const bf16* GM; const bf16* GA; bf16* MG; float* TS;
    __device__ __forceinline__ void mid(f32x4 (&acc)[2][2][4][2], const pg8::Unit& u, int wr, int wc, int fr, int fq) const {
        asm volatile("" : "+v"(fr), "+v"(fq));
        const int rbase = u.pm * 256 + wr * 64 + fr, c0 = u.pn * 256 + wc * 32 + 8 * fq;
#pragma unroll
        for (int ai = 0; ai < 2; ++ai) { u32x4 gm[4][2], ga[4][2];
#pragma unroll
            for (int m = 0; m < 4; ++m)
#pragma unroll
                for (int bj = 0; bj < 2; ++bj) { const size_t off = (size_t)(rbase + ai * 128 + m * 16) * D + c0 + bj * 128; gm[m][bj] = *(const GAS u32x4*)(GM + off); ga[m][bj] = *(const GAS u32x4*)(GA + off); }
#pragma unroll
            for (int m = 0; m < 4; ++m)
#pragma unroll
                for (int bj = 0; bj < 2; ++bj) { const u32x4 a = gm[m][bj], b = ga[m][bj];
#define RAT(x, y) ((x) * __builtin_amdgcn_rcpf(fmaxf((y), 1e-20f)))
                    acc[ai][bj][m][0][0] *= RAT(bf_lo(a.x), bf_lo(b.x)); acc[ai][bj][m][0][1] *= RAT(bf_hi(a.x), bf_hi(b.x)); acc[ai][bj][m][0][2] *= RAT(bf_lo(a.y), bf_lo(b.y)); acc[ai][bj][m][0][3] *= RAT(bf_hi(a.y), bf_hi(b.y));
                    acc[ai][bj][m][1][0] *= RAT(bf_lo(a.z), bf_lo(b.z)); acc[ai][bj][m][1][1] *= RAT(bf_hi(a.z), bf_hi(b.z)); acc[ai][bj][m][1][2] *= RAT(bf_lo(a.w), bf_lo(b.w)); acc[ai][bj][m][1][3] *= RAT(bf_hi(a.w), bf_hi(b.w));
#undef RAT
                } }
    }
    __device__ __forceinline__ void operator()(const f32x4 (&acc)[2][2][4][2], const pg8::Unit& u, int wr, int wc, int fr, int fq) const {
        asm volatile("" : "+v"(fr), "+v"(fq));
        const int rbase = u.pm * 256 + wr * 64 + fr, c0 = u.pn * 256 + wc * 32 + 8 * fq;
        const bool sp = u.nq > 1; float* ts = TS + (size_t)u.kq * MS * D - (size_t)MP * D;
        u32x4 gv[2][4][2];
        EPI_FOR3 gv[ai][m][bj] = *(const GAS u32x4*)(GA + (size_t)(rbase + ai * 128 + m * 16) * D + c0 + bj * 128);
        EPI_FOR3 { const size_t off = (size_t)(rbase + ai * 128 + m * 16) * D + c0 + bj * 128; const u32x4 g = gv[ai][m][bj];
            f32x4 v0 = acc[ai][bj][m][0], v1 = acc[ai][bj][m][1];
            v0[0] *= bf_lo(g.x); v0[1] *= bf_hi(g.x); v0[2] *= bf_lo(g.y); v0[3] *= bf_hi(g.y); v1[0] *= bf_lo(g.z); v1[1] *= bf_hi(g.z); v1[2] *= bf_lo(g.w); v1[3] *= bf_hi(g.w);
            if (sp) { *(GAS f32x4*)(ts + off) = v0; *(GAS f32x4*)(ts + off + 4) = v1; } else *(GAS u32x4*)(MG + off) = pack8(v0, v1); }
    }
};
struct EpiOut {
    static constexpr bool PERM = true, AFTER_DRAIN = false;
    const float* mod; bf16* DLT; float* PS;
    __device__ __forceinline__ void operator()(const f32x4 (&acc)[2][2][4][2], const pg8::Unit& u, int wr, int wc, int fr, int fq) const {
        const int rbase = u.pm * 256 + wr * 64 + fr, c0 = u.pn * 256 + wc * 32 + 8 * fq; const bool sp = u.nq > 1;
#pragma unroll
        for (int ai = 0; ai < 2; ++ai) { const int row0 = rbase + ai * 128; const int bi = row0 < MP ? (row0 >> 13) : 2 + ((row0 - MP) >> 6);
            const float* gp = mod + (size_t)bi * 12288 + 8192 + c0;
            f32x4 g0[2], g1[2];
#pragma unroll
            for (int bj = 0; bj < 2; ++bj) { g0[bj] = *(const GAS f32x4*)(gp + bj * 128); g1[bj] = *(const GAS f32x4*)(gp + bj * 128 + 4); }
            float* yb = PS + (size_t)u.kq * MS * D + (size_t)(row0 - MP) * D; bf16* xb = DLT + (size_t)row0 * D;
#pragma unroll
            for (int m = 0; m < 4; ++m)
#pragma unroll
                for (int bj = 0; bj < 2; ++bj) { const size_t o_ = (size_t)(m * 16) * D + c0 + bj * 128; const f32x4 r0 = g0[bj] * acc[ai][bj][m][0], r1 = g1[bj] * acc[ai][bj][m][1];
                    if (sp) { *(GAS f32x4*)(yb + o_) = r0; *(GAS f32x4*)(yb + o_ + 4) = r1; } else *(GAS u32x4*)(xb + o_) = pack8(r0, r1); } }
    }
};

#define XB_TMO      128
#define XB_XCNT(j)  (256  + 64 * (j))
#define XB_XSUB(j)  (1280 + 64 * (j))
#define XB_XGEN(j)  (2304 + 64 * (j))
#define XB_TOP      3328
#define XB_TOPGEN   3392
#define XCD_BAR_WORDS 3456
#define XB_SPIN_CAP (1u << 18)
__device__ __forceinline__ unsigned xb_ld(unsigned* p)              { return __hip_atomic_load(p, __ATOMIC_RELAXED, __HIP_MEMORY_SCOPE_AGENT); }
__device__ __forceinline__ unsigned xb_add(unsigned* p, unsigned v) { return __hip_atomic_fetch_add(p, v, __ATOMIC_RELAXED, __HIP_MEMORY_SCOPE_AGENT); }
__device__ __forceinline__ unsigned xb_xcc_id() { return (unsigned)__builtin_amdgcn_s_getreg((3 << 11) | 20) & 0xFu; }
#define XB_SPIN(cond, bar) do { unsigned _sp = 0; while (cond) { __builtin_amdgcn_s_sleep(1); \
    if ((++_sp & 255u) == 0u) { if (xb_ld(&(bar)[XB_TMO])) break; if (_sp > XB_SPIN_CAP) { atomicAdd(&(bar)[XB_TMO], 1u); break; } } } } while (0)
struct XcdBarrier { unsigned* bar; unsigned x; volatile LAS unsigned* st; };
__device__ __forceinline__ XcdBarrier xcd_barrier_post(unsigned* bar, volatile LAS unsigned* st) {
    XcdBarrier b; b.bar = bar; b.x = xb_xcc_id(); b.st = st;
    if (threadIdx.x == 0) (void)xb_add(&bar[XB_XCNT(b.x)], 1u);
    return b;
}
__device__ __forceinline__ void xcd_barrier_complete(unsigned* bar, unsigned x, unsigned& nloc, unsigned& nx) {
    const unsigned G = gridDim.x * gridDim.y * gridDim.z;
    unsigned sum, cnt, mine, sp = 0u;
    for (;;) {
        sum = 0u; cnt = 0u; mine = 0u;
#pragma unroll
        for (unsigned j = 0; j < 16; ++j) { const unsigned c = xb_ld(&bar[XB_XCNT(j)]); sum += c; cnt += (c > 0u) ? 1u : 0u; mine = (j == x) ? c : mine; }
        if (sum == G) break;
        __builtin_amdgcn_s_sleep(1);
        if ((++sp & 255u) == 0u) { if (xb_ld(&bar[XB_TMO])) break; if (sp > XB_SPIN_CAP) { atomicAdd(&bar[XB_TMO], 1u); break; } }
    }
    nloc = mine > 0u ? mine : 1u; nx = cnt > 0u ? cnt : 1u;
}
__device__ __forceinline__ void xcd_barrier(const XcdBarrier& b) {
    asm volatile("s_waitcnt vmcnt(0)" ::: "memory");
    __syncthreads();
    if (threadIdx.x == 0) {
        unsigned* bar = b.bar;
        __builtin_amdgcn_s_waitcnt(0);
        unsigned nloc = b.st[0], nx = b.st[1];
        if (nloc == 0u) { xcd_barrier_complete(bar, b.x, nloc, nx); b.st[0] = nloc; b.st[1] = nx; }
        const unsigned old = xb_add(&bar[XB_XSUB(b.x)], 1u);
        const unsigned gen = old / nloc;
        if (old + 1u == (gen + 1u) * nloc) {
            __builtin_amdgcn_fence(__ATOMIC_RELEASE, "agent");
            asm volatile("s_waitcnt vmcnt(0)" ::: "memory");
            const unsigned og = xb_add(&bar[XB_TOP], 1u);
            const unsigned tg = og / nx;
            if (og + 1u == (tg + 1u) * nx) xb_add(&bar[XB_TOPGEN], 1u);
            else XB_SPIN(xb_ld(&bar[XB_TOPGEN]) == tg, bar);
            __builtin_amdgcn_fence(__ATOMIC_ACQUIRE, "agent");
            xb_add(&bar[XB_XGEN(b.x)], 1u);
            asm volatile("s_waitcnt vmcnt(0)" ::: "memory");
        } else {
            XB_SPIN(xb_ld(&bar[XB_XGEN(b.x)]) == gen, bar);
            __builtin_amdgcn_fence(__ATOMIC_ACQUIRE, "agent");
            asm volatile("s_waitcnt vmcnt(0)" ::: "memory");
        }
    }
    __syncthreads();
}

struct Args { const float* in[27]; float* out; unsigned char* ws; int ph_lo, ph_hi; };
enum { I_XP = 0, I_XS, I_CK, I_CV, I_SCONV, I_SSSM, I_CP, I_CS, I_WADA, I_BADA, I_NORMW, I_WIN, I_CONVW, I_CONVB, I_DTB, I_ALOG, I_DSKIP, I_MNW, I_LQ1, I_LK1, I_LQ2, I_LK2, I_ANW, I_WPM, I_WPA, I_WOUT, I_FNW };

__device__ __forceinline__ void p0_transpose_item(const float* W, int K, int N, bf16* WT, int row_off, LAS float* scr, int kb, int nb, int lane) {
    const int k0 = 64 * kb, n0 = 32 * nb;
#pragma unroll 8
    for (int i = 0; i < 32; ++i) { const int kk = 2 * i + (lane >> 5); scr[kk * 33 + (lane & 31)] = *(const GAS float*)(W + (size_t)(k0 + kk) * N + n0 + (lane & 31)); }
    asm volatile("s_waitcnt lgkmcnt(0)" ::: "memory");
    const int c = lane & 7;
#pragma unroll
    for (int j = 0; j < 4; ++j) { const int n = (lane >> 3) + 8 * j; const LAS float* s = scr + (8 * c) * 33 + n;
        u32x4 o; o.x = cvt_pk_bf16(s[0 * 33], s[1 * 33]); o.y = cvt_pk_bf16(s[2 * 33], s[3 * 33]); o.z = cvt_pk_bf16(s[4 * 33], s[5 * 33]); o.w = cvt_pk_bf16(s[6 * 33], s[7 * 33]);
        *(GAS u32x4*)(WT + (size_t)(row_off + n0 + n) * K + k0 + 8 * c) = o; }
    asm volatile("s_waitcnt lgkmcnt(0)" ::: "memory");
}
__device__ __forceinline__ void p0_transpose_tile(const float* W, int K, int N, bf16* WT, int row_off, int kb, int nb, int lane) {
    const int k0 = 64 * kb + 16 * (lane >> 4), n0 = 64 * nb + 4 * (lane & 15);
    f32x4 v[16];
    const float* src = W + (size_t)k0 * N + n0;
#pragma unroll
    for (int i = 0; i < 16; ++i) v[i] = __builtin_nontemporal_load((const GAS f32x4*)(src + (size_t)i * N));
    bf16* dst = WT + (size_t)(row_off + n0) * K + k0;
#pragma unroll
    for (int e = 0; e < 4; ++e)
#pragma unroll
        for (int h = 0; h < 2; ++h) { u32x4 o; o.x = cvt_pk_bf16(v[8 * h][e], v[8 * h + 1][e]); o.y = cvt_pk_bf16(v[8 * h + 2][e], v[8 * h + 3][e]); o.z = cvt_pk_bf16(v[8 * h + 4][e], v[8 * h + 5][e]); o.w = cvt_pk_bf16(v[8 * h + 6][e], v[8 * h + 7][e]);
            *(GAS u32x4*)(dst + (size_t)e * K + 8 * h) = o; }
}
__device__ __forceinline__ void phase_prologue(const Args& a, LAS unsigned char* lds, int tid, int bx, int G, bool do_mod = true) {
    const int lane = tid & 63, wave = __builtin_amdgcn_readfirstlane(tid >> 6);
    const int gw = bx * 8 + wave, NGW = G * 8, gt = bx * 512 + tid, NGT = G * 512;
    if (do_mod) for (int task = bx; task < 192; task += G) {
        const int ks = task / 6, cg = task % 6, k0 = ks * 128;
        LAS float* sc = (LAS float*)lds;
        for (int i = tid; i < 18 * 128; i += 512) { const int b = i >> 7, k = i & 127; const float c = (b < 2) ? a.in[I_CP][b * D + k0 + k] : a.in[I_CS][(b - 2) * D + k0 + k]; sc[k * 20 + b] = silu_f(c); }
        __syncthreads();
        const int col = cg * 2048 + wave * 256 + lane * 4;
        f32x4 acc[18];
#pragma unroll
        for (int b = 0; b < 18; ++b) acc[b] = (f32x4){0.f, 0.f, 0.f, 0.f};
        const float* wp = a.in[I_WADA] + (size_t)k0 * 12288 + col;
#pragma unroll 8
        for (int k = 0; k < 128; ++k) { const f32x4 w = __builtin_nontemporal_load((const GAS f32x4*)(wp + (size_t)k * 12288));
            const LAS f32x4* s4 = (const LAS f32x4*)(sc + k * 20);
            const f32x4 s0 = s4[0], s1 = s4[1], s2 = s4[2], s3 = s4[3], s4v = s4[4];
            acc[0] += s0[0] * w; acc[1] += s0[1] * w; acc[2] += s0[2] * w; acc[3] += s0[3] * w; acc[4] += s1[0] * w; acc[5] += s1[1] * w; acc[6] += s1[2] * w; acc[7] += s1[3] * w;
            acc[8] += s2[0] * w; acc[9] += s2[1] * w; acc[10] += s2[2] * w; acc[11] += s2[3] * w; acc[12] += s3[0] * w; acc[13] += s3[1] * w; acc[14] += s3[2] * w; acc[15] += s3[3] * w;
            acc[16] += s4v[0] * w; acc[17] += s4v[1] * w; }
        float* mod = (float*)(a.ws + WS_MOD);
        f32x4 bias = (f32x4){0.f, 0.f, 0.f, 0.f}; if (ks == 0) bias = *(const GAS f32x4*)(a.in[I_BADA] + col);
#pragma unroll
        for (int b = 0; b < 18; ++b)
#pragma unroll
            for (int e = 0; e < 4; ++e) unsafeAtomicAdd(mod + (size_t)b * 12288 + col + e, acc[b][e] + bias[e]);
        __syncthreads();
    }
    { float* rope = (float*)(a.ws + WS_ROPE);
      const float invf[8] = {1.0f, 0.1939227432012558f, 0.03760603070259094f, 0.007292664609849453f, 0.0014142135623842478f, 0.00027424818836152554f, 5.3182957344688475e-05f, 1.0313385246263351e-05f};
      for (int i = gt; i < 8192 * 8; i += NGT) { const int pos = i >> 3, k = i & 7; float inv = invf[0];
#pragma unroll
          for (int q = 1; q < 8; ++q) inv = (k == q) ? invf[q] : inv;
          const float ang = (float)pos * inv; const double ad = (double)ang; const double nrev = __builtin_rint(ad * 0.15915494309189535); const float r = (float)(ad - nrev * 6.283185307179586);
          rope[pos * 16 + k] = __cosf(r); rope[pos * 16 + 8 + k] = __sinf(r); } }
    { constexpr int NB_IN = 36992 / 64, I_IN = 64 * NB_IN, I_PM = 128 * 64, I_PA = 64 * 64, I_OUT = 64 * 64, NIT = I_IN + I_PM + I_PA + I_OUT;
      for (int it = gw; it < NIT; it += NGW) { int r = it;
          if (r < I_IN) { const int kb = r / NB_IN, nb = r % NB_IN, n0 = nb * 64; const int off = n0 < 18432 ? 0 : (n0 < 18560 ? 36864 - 18432 : -128);
              p0_transpose_tile(a.in[I_WIN], D, 36992, (bf16*)(a.ws + WS_WIN), off, kb, nb, lane); continue; } r -= I_IN;
          if (r < I_PM) { p0_transpose_tile(a.in[I_WPM], DI, D, (bf16*)(a.ws + WS_WPM), 0, r / 64, r % 64, lane); continue; } r -= I_PM;
          if (r < I_PA) { p0_transpose_tile(a.in[I_WPA], D, D, (bf16*)(a.ws + WS_WPA), 0, r / 64, r % 64, lane); continue; } r -= I_PA;
          p0_transpose_tile(a.in[I_WOUT], D, D, (bf16*)(a.ws + WS_WOUT), 0, r / 64, r % 64, lane); }
      u32x4* padp = (u32x4*)((bf16*)(a.ws + WS_WIN) + (size_t)36992 * D);
      for (int i = gt; i < 128 * D / 8; i += NGT) *(GAS u32x4*)(padp + i) = (u32x4){0u, 0u, 0u, 0u}; }
    for (int i = gt; i < 2 * 4194304; i += NGT) { const int which = i >= 4194304, j = which ? i - 4194304 : i; const size_t src = (size_t)j * 8; const int b = j >> 18;
        const float* sp = a.in[which ? I_CV : I_CK] + src; const f32x4 v0 = *(const GAS f32x4*)sp, v1 = *(const GAS f32x4*)(sp + 4);
        *(GAS u32x4*)((bf16*)(a.ws + (which ? WS_VS : WS_KS)) + src + (size_t)b * 65536) = pack8(v0, v1); }
}
__device__ __forceinline__ void phase_h(const Args& a, int tid, int bx, int G, size_t hoff = WS_H) {
    const int lane = tid & 63, wave = tid >> 6, gw = bx * 8 + wave, NGW = G * 8;
    const float* mod = (const float*)(a.ws + WS_MOD); bf16* H = (bf16*)(a.ws + hoff);
    constexpr int NPAIR = M / 2; const int nfull = (NPAIR / NGW) * NGW, nrem = NPAIR - nfull;
    const int rstep = nrem > 0 ? NGW / nrem : 1;
    for (int i = 0;; ++i) {
        int rp;
        if ((i + 1) * NGW <= nfull) rp = i * NGW + gw;
        else { if (nrem == 0 || gw % rstep != 0 || gw / rstep >= nrem) break; rp = nfull + gw / rstep; }
        const int row = 2 * rp;
        const float* xr = row < MP ? a.in[I_XP] + (size_t)row * D : a.in[I_XS] + (size_t)(row - MP) * D; const int bi = row < MP ? (row >> 13) : 2 + ((row - MP) >> 6);
        f32x4 v[2][8][2]; float s0 = 0.f, s1 = 0.f;
#pragma unroll
        for (int q = 0; q < 2; ++q)
#pragma unroll
            for (int j = 0; j < 8; ++j) { v[q][j][0] = *(const GAS f32x4*)(xr + q * D + 8 * (64 * j + lane)); v[q][j][1] = *(const GAS f32x4*)(xr + q * D + 8 * (64 * j + lane) + 4); }
#pragma unroll
        for (int j = 0; j < 8; ++j) {
            s0 += (v[0][j][0][0] * v[0][j][0][0] + v[0][j][0][1] * v[0][j][0][1]) + (v[0][j][0][2] * v[0][j][0][2] + v[0][j][0][3] * v[0][j][0][3]) + (v[0][j][1][0] * v[0][j][1][0] + v[0][j][1][1] * v[0][j][1][1]) + (v[0][j][1][2] * v[0][j][1][2] + v[0][j][1][3] * v[0][j][1][3]);
            s1 += (v[1][j][0][0] * v[1][j][0][0] + v[1][j][0][1] * v[1][j][0][1]) + (v[1][j][0][2] * v[1][j][0][2] + v[1][j][0][3] * v[1][j][0][3]) + (v[1][j][1][0] * v[1][j][1][0] + v[1][j][1][1] * v[1][j][1][1]) + (v[1][j][1][2] * v[1][j][1][2] + v[1][j][1][3] * v[1][j][1][3]); }
        const float rstd0 = 1.f / sqrtf(wave_sum(s0) * (1.f / D) + EPS), rstd1 = 1.f / sqrtf(wave_sum(s1) * (1.f / D) + EPS);
        const float* sh = mod + (size_t)bi * 12288; const float* scl = sh + 4096; const float* nw = a.in[I_NORMW];
#pragma unroll
        for (int j = 0; j < 8; ++j) { const int c = 8 * (64 * j + lane);
#pragma unroll
            for (int h = 0; h < 2; ++h) { const f32x4 w = *(const GAS f32x4*)(nw + c + 4 * h), sc = *(const GAS f32x4*)(scl + c + 4 * h), sf = *(const GAS f32x4*)(sh + c + 4 * h);
                const f32x4 m = w * (1.f + sc);
                v[0][j][h] = v[0][j][h] * rstd0 * m + sf; v[1][j][h] = v[1][j][h] * rstd1 * m + sf; }
            *(GAS u32x4*)(H + (size_t)row * D + c) = pack8(v[0][j][0], v[0][j][1]); *(GAS u32x4*)(H + (size_t)(row + 1) * D + c) = pack8(v[1][j][0], v[1][j][1]); }
        if ((i + 1) * NGW > nfull) break;
    }
}
__device__ __forceinline__ void phase_conv(const Args& a, int tid, int bx, int G) {
    const int lane = tid & 63, wave = tid >> 6, gw = bx * 8 + wave, NGW = G * 8;
    const bf16* XBC = (const bf16*)(a.ws + WS_XBC);
    for (int u = gw; u < 272 * 80; u += NGW) {
        const int ch = u / 80, cb = u % 80, c = cb * 128 + 2 * lane, m0 = ch * 64;
        const f32x2 w0 = *(const GAS f32x2*)(a.in[I_CONVW] + c), w1 = *(const GAS f32x2*)(a.in[I_CONVW] + CD + c), w2 = *(const GAS f32x2*)(a.in[I_CONVW] + 2 * CD + c), w3 = *(const GAS f32x2*)(a.in[I_CONVW] + 3 * CD + c), bias = *(const GAS f32x2*)(a.in[I_CONVB] + c);
        f32x2 x0 = {0.f, 0.f}, x1 = {0.f, 0.f}, x2 = {0.f, 0.f};
        if (ch >= 256) { const float* sp = a.in[I_SCONV] + (size_t)(ch - 256) * 3 * CD + c; x0 = *(const GAS f32x2*)sp; x1 = *(const GAS f32x2*)(sp + CD); x2 = *(const GAS f32x2*)(sp + 2 * CD); }
        else if ((ch & 127) != 0) { const bf16* pp = XBC + (size_t)(m0 - 3) * CD + c; const unsigned r0 = *(const GAS unsigned*)pp, r1 = *(const GAS unsigned*)(pp + CD), r2 = *(const GAS unsigned*)(pp + 2 * CD);
            x0 = (f32x2){bf_lo(r0), bf_hi(r0)}; x1 = (f32x2){bf_lo(r1), bf_hi(r1)}; x2 = (f32x2){bf_lo(r2), bf_hi(r2)}; }
        unsigned pkA[32], pkB[32];
        const bf16* src = XBC + (size_t)m0 * CD + c;
#pragma unroll
        for (int tb = 0; tb < 4; ++tb) { unsigned raw[16];
#pragma unroll
            for (int i = 0; i < 16; ++i) raw[i] = *(const GAS unsigned*)(src + (size_t)(tb * 16 + i) * CD);
#pragma unroll
            for (int i = 0; i < 16; i += 2) { const f32x2 xa = {bf_lo(raw[i]), bf_hi(raw[i])}, xb = {bf_lo(raw[i + 1]), bf_hi(raw[i + 1])};
                const f32x2 ta = bias + w0 * x0 + w1 * x1 + w2 * x2 + w3 * xa, tb2 = bias + w0 * x1 + w1 * x2 + w2 * xa + w3 * xb;
                x0 = x2; x1 = xa; x2 = xb;
                pkA[tb * 8 + (i >> 1)] = cvt_pk_bf16(silu_f(ta[0]), silu_f(tb2[0])); pkB[tb * 8 + (i >> 1)] = cvt_pk_bf16(silu_f(ta[1]), silu_f(tb2[1])); } }
        if (cb < 64) {
            u32x4* dst = (u32x4*)((bf16*)(a.ws + WS_XT) + ((size_t)(ch * 128 + 2 * cb + (lane >> 5)) * 64 + 2 * (lane & 31)) * 64);
#pragma unroll
            for (int i = 0; i < 8; ++i) { *(GAS u32x4*)(dst + i) = (u32x4){pkA[4 * i], pkA[4 * i + 1], pkA[4 * i + 2], pkA[4 * i + 3]}; *(GAS u32x4*)(dst + 8 + i) = (u32x4){pkB[4 * i], pkB[4 * i + 1], pkB[4 * i + 2], pkB[4 * i + 3]}; }
        } else {
            const int q = cb - 64, isC = q >= 8, g = q & 7, n = 2 * lane;
            unsigned* nat = (unsigned*)((bf16*)(a.ws + (isC ? WS_CN : WS_BN)) + (size_t)(ch * 8 + g) * 8192 + n);
#pragma unroll
            for (int i = 0; i < 32; ++i) { *(GAS unsigned*)(nat + (size_t)(2 * i) * 64) = (pkA[i] & 0xffffu) | (pkB[i] << 16); *(GAS unsigned*)(nat + (size_t)(2 * i + 1) * 64) = (pkA[i] >> 16) | (pkB[i] & 0xffff0000u); }
            if (!isC) { u32x4* dst = (u32x4*)((bf16*)(a.ws + WS_BT) + (size_t)(ch * 8 + g) * 8192 + (size_t)n * 64);
#pragma unroll
                for (int i = 0; i < 8; ++i) { *(GAS u32x4*)(dst + i) = (u32x4){pkA[4 * i], pkA[4 * i + 1], pkA[4 * i + 2], pkA[4 * i + 3]}; *(GAS u32x4*)(dst + 8 + i) = (u32x4){pkB[4 * i], pkB[4 * i + 1], pkB[4 * i + 2], pkB[4 * i + 3]}; } }
        }
    }
}

constexpr int L_BN = 0, L_CN = 17408, L_BT = 34816, L_XT = 53248, L_XT2 = 62464, L_G = 71680, L_SP = 80896, L_SC = 115712, L_Z = 117888, L_Y = 127104;
static_assert(L_Y + 9216 <= LDSCTL_OFF, "SSD LDS map");
#define MFMA32(a, b, c) __builtin_amdgcn_mfma_f32_32x32x16_bf16((a), (b), (c), 0, 0, 0)
__device__ __forceinline__ float dpp_add(float v, float x) { return v + x; }
__device__ __forceinline__ float wave_incl_scan(float v) {
#define DPPF(x, ctrl, rmask, bc) __builtin_bit_cast(float, __builtin_amdgcn_update_dpp(0, __builtin_bit_cast(int, (x)), (ctrl), (rmask), 0xf, (bc)))
    v += DPPF(v, 0x111, 0xf, true); v += DPPF(v, 0x112, 0xf, true); v += DPPF(v, 0x114, 0xf, true); v += DPPF(v, 0x118, 0xf, true);
    v += DPPF(v, 0x142, 0xa, false); v += DPPF(v, 0x143, 0xc, false);
#undef DPPF
    return v;
}
__device__ __forceinline__ void ssd_scan(LAS float* SC, float dtv, float a_h, int lane) {
    const float v = wave_incl_scan(dtv * a_h);
    const float tot = __builtin_bit_cast(float, __builtin_amdgcn_readlane(__builtin_bit_cast(int, v), 63));
    SC[lane] = v; SC[64 + lane] = dtv; SC[128 + lane] = dtv * __expf(tot - v); SC[192 + lane] = __expf(v); if (lane == 0) SC[256] = __expf(tot);
}
template <int PMODE> __device__ __forceinline__ void ssd_unit(const Args& a, LAS unsigned char* L, int tid, int ch0, int NC, int m0, int hd, const float* s_init, float* s_out, const bool pcs) {
    constexpr size_t SSTR = (size_t)128 * 8192;
    asm volatile("" : "+v"(tid));
    const int lane = tid & 63, wid = __builtin_amdgcn_readfirstlane(tid >> 6), r32 = lane & 31, hi = lane >> 5, g = hd >> 4;
    const float a_h = -expf(a.in[I_ALOG][hd]), dsk = a.in[I_DSKIP][hd];
    const unsigned char* gBN = a.ws + WS_BN; const unsigned char* gCN = a.ws + WS_CN; const unsigned char* gBT = a.ws + WS_BT; const unsigned char* gXT = a.ws + WS_XT;
    const float* DT = (const float*)(a.ws + WS_DT); const bf16* ZM = (const bf16*)(a.ws + WS_ZM); bf16* YM = (bf16*)(a.ws + (PMODE ? WS_XBC + 64 * MiB : WS_YM));
    u32x4 sBN[2], sCN[2], sBT[2], sXT, sZ; float dtn = 0.f;
#define SSD_ISSUE(ch) do { const size_t tg = (size_t)((ch) * 8 + g) * 16384; _Pragma("unroll") for (int i = 0; i < 2; ++i) { const size_t o = tg + (size_t)(tid + 512 * i) * 16; \
        sBN[i] = *(const GAS u32x4*)(gBN + o); sCN[i] = *(const GAS u32x4*)(gCN + o); sBT[i] = *(const GAS u32x4*)(gBT + o); } \
        sXT = *(const GAS u32x4*)(gXT + (size_t)((ch) * 128 + hd) * 8192 + (size_t)tid * 16); \
        sZ = *(const GAS u32x4*)(ZM + (size_t)(m0 + ((ch) - ch0) * 64 + (tid >> 3)) * DI + hd * 64 + (tid & 7) * 8); } while (0)
#define SSD_COMMIT() do { _Pragma("unroll") for (int i = 0; i < 2; ++i) { const int idx = tid + 512 * i; \
        *(LAS u32x4*)(L + L_BN + (idx >> 4) * 272 + (idx & 15) * 16) = sBN[i]; *(LAS u32x4*)(L + L_CN + (idx >> 4) * 272 + (idx & 15) * 16) = sCN[i]; \
        *(LAS u32x4*)(L + L_BT + (idx >> 3) * 144 + (idx & 7) * 16) = sBT[i]; } \
        *(LAS u32x4*)(L + L_XT + (tid >> 3) * 144 + (tid & 7) * 16) = sXT; *(LAS u32x4*)(L + L_Z + (tid >> 3) * 144 + (tid & 7) * 16) = sZ; } while (0)
    f32x16 st[2], sn[2];
    int sofs = r32 * 128 + ((wid - 4) & 3) * 32 + 4 * hi; asm volatile("" : "+v"(sofs));
#pragma unroll
    for (int r = 0; r < 16; ++r) { st[0][r] = 0.f; st[1][r] = 0.f; sn[0][r] = 0.f; sn[1][r] = 0.f; }
    LBAR();
    SSD_ISSUE(ch0);
    if (wid == 4) ssd_scan((LAS float*)(L + L_SC), *(const GAS float*)(DT + (size_t)(m0 + lane) * NH + hd), a_h, lane);
    if (wid >= 4) { const int nb = wid - 4;
        if (s_init) {
#pragma unroll
            for (int pb = 0; pb < 2; ++pb)
#pragma unroll
                for (int g4 = 0; g4 < 4; ++g4) { const f32x4 v = *(const GAS f32x4*)(s_init + sofs + pb * 4096 + 8 * g4);
                    st[pb][4 * g4] = v[0]; st[pb][4 * g4 + 1] = v[1]; st[pb][4 * g4 + 2] = v[2]; st[pb][4 * g4 + 3] = v[3]; }
        }
#pragma unroll
        for (int pb = 0; pb < 2; ++pb)
#pragma unroll
            for (int g4 = 0; g4 < 4; ++g4) { u32x2 w; w.x = cvt_pk_bf16(st[pb][4 * g4], st[pb][4 * g4 + 1]); w.y = cvt_pk_bf16(st[pb][4 * g4 + 2], st[pb][4 * g4 + 3]);
                *(LAS u32x2*)(L + L_SP + (pb * 32 + r32) * 272 + (nb * 32 + 8 * g4 + 4 * hi) * 2) = w; }
    }
    SSD_COMMIT();
    LBAR();
    int cur = 0;
    for (int c = 0; c < NC; ++c) {
        const int mc = m0 + c * 64; const bool has_next = c + 1 < NC;
        LAS float* SC = (LAS float*)(L + L_SC) + cur * 272;
        if (has_next && PMODE != 1) {
            if (pcs && wid >= 4) { const float* sp = s_init + (size_t)(c + 1) * SSTR;
#pragma unroll
                for (int pb = 0; pb < 2; ++pb)
#pragma unroll
                    for (int g4 = 0; g4 < 4; ++g4) { const f32x4 v = *(const GAS f32x4*)(sp + sofs + pb * 4096 + 8 * g4);
                        sn[pb][4 * g4] = v[0]; sn[pb][4 * g4 + 1] = v[1]; sn[pb][4 * g4 + 2] = v[2]; sn[pb][4 * g4 + 3] = v[3]; } }
            SSD_ISSUE(ch0 + c + 1); if (wid == 4) dtn = *(const GAS float*)(DT + (size_t)(mc + 64 + lane) * NH + hd); }
        if (wid < 4) {
            const int lb = wid >> 1, pb = wid & 1;
            if (wid != 1) { const int sb = wid & 1, l = lb * 32 + r32; f32x16 cb;
#pragma unroll
                for (int r = 0; r < 16; ++r) cb[r] = 0.f;
                LAS const unsigned char* pa = L + L_BN + (sb * 32 + r32) * 272 + hi * 16; LAS const unsigned char* pbb = L + L_CN + (lb * 32 + r32) * 272 + hi * 16;
#pragma unroll
                for (int kh = 0; kh < 2; ++kh) { bf16x8 fa[4], fb[4];
#pragma unroll
                    for (int k = 0; k < 4; ++k) { fa[k] = *(LAS const bf16x8*)(pa + (kh * 4 + k) * 32); fb[k] = *(LAS const bf16x8*)(pbb + (kh * 4 + k) * 32); }
                    __builtin_amdgcn_sched_barrier(0);
#pragma unroll
                    for (int k = 0; k < 4; ++k) cb = MFMA32(fa[k], fb[k], cb);
                    __builtin_amdgcn_sched_barrier(0); }
                const float al = SC[l];
#pragma unroll
                for (int g4 = 0; g4 < 4; ++g4) { const int s0 = sb * 32 + 8 * g4 + 4 * hi; const f32x4 as = *(LAS const f32x4*)(SC + s0), ds = *(LAS const f32x4*)(SC + 64 + s0); float gv[4];
#pragma unroll
                    for (int e = 0; e < 4; ++e) { const float t = cb[4 * g4 + e] * __expf(al - as[e]) * ds[e]; gv[e] = (s0 + e <= l) ? t : 0.f; }
                    u32x2 w; w.x = cvt_pk_bf16(gv[0], gv[1]); w.y = cvt_pk_bf16(gv[2], gv[3]); *(LAS u32x2*)(L + L_G + l * 144 + s0 * 2) = w; } }
        } else { const int t2 = tid - 256, p = t2 >> 2, seg = t2 & 3;
            LAS const unsigned char* src = L + L_XT + p * 144 + seg * 32; const u32x4 v0 = *(LAS const u32x4*)src, v1 = *(LAS const u32x4*)(src + 16);
            LAS const f32x4* wp = (LAS const f32x4*)(SC + 128 + seg * 16); const f32x4 wa = wp[0], wb = wp[1], wc4 = wp[2], wd = wp[3];
            u32x4 o0, o1;
            o0.x = cvt_pk_bf16(bf_lo(v0.x) * wa[0], bf_hi(v0.x) * wa[1]); o0.y = cvt_pk_bf16(bf_lo(v0.y) * wa[2], bf_hi(v0.y) * wa[3]); o0.z = cvt_pk_bf16(bf_lo(v0.z) * wb[0], bf_hi(v0.z) * wb[1]); o0.w = cvt_pk_bf16(bf_lo(v0.w) * wb[2], bf_hi(v0.w) * wb[3]);
            o1.x = cvt_pk_bf16(bf_lo(v1.x) * wc4[0], bf_hi(v1.x) * wc4[1]); o1.y = cvt_pk_bf16(bf_lo(v1.y) * wc4[2], bf_hi(v1.y) * wc4[3]); o1.z = cvt_pk_bf16(bf_lo(v1.z) * wd[0], bf_hi(v1.z) * wd[1]); o1.w = cvt_pk_bf16(bf_lo(v1.w) * wd[2], bf_hi(v1.w) * wd[3]);
            LAS unsigned char* dst = L + L_XT2 + p * 144 + seg * 32; *(LAS u32x4*)dst = o0; *(LAS u32x4*)(dst + 16) = o1; }
        LBAR();
        if (wid < 4) { const int lb = wid >> 1, pb = wid & 1; f32x16 y;
#pragma unroll
            for (int r = 0; r < 16; ++r) y[r] = 0.f;
            { LAS const unsigned char* pa = L + L_CN + (lb * 32 + r32) * 272 + hi * 16; LAS const unsigned char* pbb = L + L_SP + cur * 17408 + (pb * 32 + r32) * 272 + hi * 16;
#pragma unroll
              for (int kh = 0; kh < 2; ++kh) { bf16x8 fa[4], fb[4];
#pragma unroll
                  for (int k = 0; k < 4; ++k) { fa[k] = *(LAS const bf16x8*)(pa + (kh * 4 + k) * 32); fb[k] = *(LAS const bf16x8*)(pbb + (kh * 4 + k) * 32); }
                  __builtin_amdgcn_sched_barrier(0);
#pragma unroll
                  for (int k = 0; k < 4; ++k) y = MFMA32(fa[k], fb[k], y);
                  __builtin_amdgcn_sched_barrier(0); } }
            bf16x8 ga[4], xb[4];
            { LAS const unsigned char* pa = L + L_G + (lb * 32 + r32) * 144 + hi * 16; LAS const unsigned char* pbb = L + L_XT + (pb * 32 + r32) * 144 + hi * 16;
              ga[0] = *(LAS const bf16x8*)(pa); xb[0] = *(LAS const bf16x8*)(pbb); ga[1] = *(LAS const bf16x8*)(pa + 32); xb[1] = *(LAS const bf16x8*)(pbb + 32);
              if (lb) { ga[2] = *(LAS const bf16x8*)(pa + 64); xb[2] = *(LAS const bf16x8*)(pbb + 64); ga[3] = *(LAS const bf16x8*)(pa + 96); xb[3] = *(LAS const bf16x8*)(pbb + 96); } }
#pragma unroll
            for (int g4 = 0; g4 < 4; ++g4) { const f32x4 e4 = *(LAS const f32x4*)(SC + 192 + lb * 32 + 8 * g4 + 4 * hi); y[4 * g4] *= e4[0]; y[4 * g4 + 1] *= e4[1]; y[4 * g4 + 2] *= e4[2]; y[4 * g4 + 3] *= e4[3]; }
            y = MFMA32(ga[0], xb[0], y); y = MFMA32(ga[1], xb[1], y);
            if (lb) { y = MFMA32(ga[2], xb[2], y); y = MFMA32(ga[3], xb[3], y); }
            const int p = pb * 32 + r32;
#pragma unroll
            for (int g4 = 0; g4 < 4; ++g4) { const int l0 = lb * 32 + 8 * g4 + 4 * hi; const u32x2 xv = *(LAS const u32x2*)(L + L_XT + p * 144 + l0 * 2);
                const float xe[4] = {bf_lo(xv.x), bf_hi(xv.x), bf_lo(xv.y), bf_hi(xv.y)};
#pragma unroll
                for (int e = 0; e < 4; ++e) { const float zz = bf2f(*(LAS const bf16*)(L + L_Z + (l0 + e) * 144 + p * 2)); const float yv = (y[4 * g4 + e] + dsk * xe[e]) * zz; *(LAS bf16*)(L + L_Y + (l0 + e) * 144 + p * 2) = f2bf(yv); } }
        } else { const int nb = wid - 4; const float dA = SC[256];
#pragma unroll
            for (int r = 0; r < 16; ++r) { st[0][r] *= dA; st[1][r] *= dA; }
            LAS const unsigned char* pa = L + L_BT + (nb * 32 + r32) * 144 + hi * 16; bf16x8 af[4], x0f[4], x1f[4];
#pragma unroll
            for (int ks = 0; ks < 4; ++ks) { af[ks] = *(LAS const bf16x8*)(pa + ks * 32); x0f[ks] = *(LAS const bf16x8*)(L + L_XT2 + r32 * 144 + hi * 16 + ks * 32); x1f[ks] = *(LAS const bf16x8*)(L + L_XT2 + (32 + r32) * 144 + hi * 16 + ks * 32); }
            __builtin_amdgcn_sched_barrier(0);
#pragma unroll
            for (int ks = 0; ks < 4; ++ks) { st[0] = MFMA32(af[ks], x0f[ks], st[0]); st[1] = MFMA32(af[ks], x1f[ks], st[1]); }
            __builtin_amdgcn_sched_barrier(0);
            if (wid == 4 && has_next) ssd_scan((LAS float*)(L + L_SC) + (cur ^ 1) * 272, dtn, a_h, lane);
            if (pcs) { float* so = s_out + (size_t)c * SSTR;
#pragma unroll
                for (int pb = 0; pb < 2; ++pb)
#pragma unroll
                    for (int g4 = 0; g4 < 4; ++g4) *(GAS f32x4*)(so + sofs + pb * 4096 + 8 * g4) = (f32x4){st[pb][4 * g4], st[pb][4 * g4 + 1], st[pb][4 * g4 + 2], st[pb][4 * g4 + 3]};
                st[0] = sn[0]; st[1] = sn[1]; }
#pragma unroll
            for (int pb = 0; pb < 2; ++pb)
#pragma unroll
                for (int g4 = 0; g4 < 4; ++g4) { u32x2 w; w.x = cvt_pk_bf16(st[pb][4 * g4], st[pb][4 * g4 + 1]); w.y = cvt_pk_bf16(st[pb][4 * g4 + 2], st[pb][4 * g4 + 3]);
                    *(LAS u32x2*)(L + L_SP + (cur ^ 1) * 17408 + (pb * 32 + r32) * 272 + (nb * 32 + 8 * g4 + 4 * hi) * 2) = w; }
        }
        LBAR();
        *(GAS u32x4*)(YM + (size_t)(mc + (tid >> 3)) * DI + hd * 64 + (tid & 7) * 8) = *(LAS const u32x4*)(L + L_Y + (tid >> 3) * 144 + (tid & 7) * 16);
        if (has_next) { SSD_COMMIT(); }
        LBAR();
        cur ^= 1;
    }
    if (!pcs && wid >= 4) { const int nb = wid - 4;
#pragma unroll
        for (int pb = 0; pb < 2; ++pb)
#pragma unroll
            for (int g4 = 0; g4 < 4; ++g4) *(GAS f32x4*)(s_out + sofs + pb * 4096 + 8 * g4) = (f32x4){st[pb][4 * g4], st[pb][4 * g4 + 1], st[pb][4 * g4 + 2], st[pb][4 * g4 + 3]};
    }
#undef SSD_ISSUE
#undef SSD_COMMIT
}

constexpr int A_K = 0, A_V = 24576, A_WS = 73728, A_Q = 75776;
__device__ __forceinline__ void glds16(const void* gsrc, unsigned lds_dst) { unsigned keep;
    asm volatile("s_mov_b32 %0, m0\n\ts_mov_b32 m0, %2\n\ts_nop 0\n\tglobal_load_lds_dwordx4 %1, off\n\ts_mov_b32 m0, %0" : "=&s"(keep) : "v"(gsrc), "s"(lds_dst) : "memory"); }
__device__ __forceinline__ void glds16s(const void* sbase, unsigned voff, unsigned lds_dst) { unsigned keep;
    asm volatile("s_mov_b32 %0, m0\n\ts_mov_b32 m0, %3\n\ts_nop 0\n\tglobal_load_lds_dwordx4 %1, %2\n\ts_mov_b32 m0, %0" : "=&s"(keep) : "v"(voff), "s"(sbase), "s"(lds_dst) : "memory"); }
#define AWAIT_BAR(N) asm volatile("s_waitcnt vmcnt(" #N ") lgkmcnt(0)\n\ts_barrier" ::: "memory")
#define ABAR() asm volatile("s_waitcnt lgkmcnt(0)\n\ts_barrier" ::: "memory")
__device__ __forceinline__ float max3f(float a, float b, float c) { float r; asm("v_max3_f32 %0, %1, %2, %3" : "=v"(r) : "v"(a), "v"(b), "v"(c)); return r; }
__device__ __forceinline__ int crow(int r, int hi) { return (r & 3) + 8 * (r >> 2) + 4 * hi; }
template <int PMODE> __device__ __forceinline__ void attn_unit(const bf16* Kb, const bf16* Vb, int NT, const bf16* Qb, bf16* Ya, const bf16* Za, const float* anw, float* park, float lam, LAS unsigned char* shm, int tid,
                                                                     const bf16* Kbn, const bf16* Vbn, int NTn, const bf16* Qbn, bool pre, bf16x8 (&qx)[4]) {
    const int lane = tid & 63, r32 = lane & 31, hi = lane >> 5, wid = __builtin_amdgcn_readfirstlane(tid >> 6), rep = wid >> 1, th = wid & 1, half = wid >> 2;
    const unsigned lds0 = (unsigned)(uintptr_t)shm;
    LAS float* wsf = (LAS float*)(shm + A_WS) + wid * 64;
    const int vb0 = (int)(lds0 + A_V) + ((lane >> 4) & 1) * 32 + (lane & 3) * 8 + (4 * hi + ((lane & 15) >> 2)) * 64;
    for (int c = 0; c < 2; ++c) {
        const unsigned kvoff = (unsigned)(lane * 2048 + wid * 16 + c * 128);
        const unsigned vvoff = (unsigned)((16 * (wid & 3) + (lane >> 2)) * 2048 + (wid >> 2) * 64 + (lane & 3) * 16);
        const unsigned kdst = lds0 + A_K + wid * 1024, vdst0 = lds0 + A_V + wid * 1024, vdst1 = vdst0 + 8192;
#define ADMA_K(t, slot) glds16s((const char*)Kb + (size_t)(t) * 131072, kvoff, (unsigned)__builtin_amdgcn_readfirstlane(kdst + (slot) * 8192))
#define ADMA_V(t, slot) do { glds16s((const char*)Vb + (size_t)(t) * 131072, vvoff, (unsigned)__builtin_amdgcn_readfirstlane(vdst0 + (slot) * 16384)); glds16s((const char*)Vb + (size_t)(t) * 131072 + 128, vvoff, (unsigned)__builtin_amdgcn_readfirstlane(vdst1 + (slot) * 16384)); } while (0)
#define KLOAD(slot) do { LAS const unsigned char* kb_ = shm + A_K + (slot) * 8192 + hi * 1024 + r32 * 16; _Pragma("unroll") for (int d0 = 0; d0 < 4; ++d0) { kf[2 * d0] = *(LAS const bf16x8*)(kb_ + d0 * 2048); kf[2 * d0 + 1] = *(LAS const bf16x8*)(kb_ + d0 * 2048 + 512); } } while (0)
#define QLOAD() do { _Pragma("unroll") for (int d0 = 0; d0 < 4; ++d0) qr[d0] = *(LAS const bf16x8*)(qlds + d0 * 1024); } while (0)
#define QKT() do { p0 = MFMA32(kf[0], qr[0], zero16); p1 = MFMA32(kf[1], qr[0], zero16); _Pragma("unroll") for (int d0 = 1; d0 < 4; ++d0) { p0 = MFMA32(kf[2 * d0], qr[d0], p0); p1 = MFMA32(kf[2 * d0 + 1], qr[d0], p1); } } while (0)
        AWAIT_BAR(0);
        const bool have = (c == 0) && pre;
        if (!have) { ADMA_K(0, 0); ADMA_V(0, 0); if (NT > 1) { ADMA_K(1, 1); ADMA_V(1, 1); } if (NT > 2) ADMA_K(2, 2); }
        LAS unsigned char* qlds; { bf16x8 qr[4];
        if (have) {
#pragma unroll
            for (int d0 = 0; d0 < 4; ++d0) qr[d0] = qx[d0];
        } else {
#pragma unroll
            for (int d0 = 0; d0 < 4; ++d0) qr[d0] = *(const GAS bf16x8*)(Qb + (size_t)(32 * th + r32) * D + rep * 128 + c * 64 + d0 * 16 + hi * 8);
        }
        asm volatile("" : "+v"(qr[0]), "+v"(qr[1]), "+v"(qr[2]), "+v"(qr[3]));
        qlds = shm + A_Q + wid * 4096 + lane * 16;
#pragma unroll
        for (int d0 = 0; d0 < 4; ++d0) *(LAS bf16x8*)(qlds + d0 * 1024) = qr[d0]; }
        f32x16 o[4];
#pragma unroll
        for (int d = 0; d < 4; ++d)
#pragma unroll
            for (int r = 0; r < 16; ++r) o[d][r] = 0.f;
        float mref = 0.f, lsum = 0.f; int anyref = 0;
        f32x16 pA0, pA1, pB0, pB1;
        const f32x16 zero16 = {0.f, 0.f, 0.f, 0.f, 0.f, 0.f, 0.f, 0.f, 0.f, 0.f, 0.f, 0.f, 0.f, 0.f, 0.f, 0.f};
        int s0 = 0, s1 = 1, s2 = 2;
        AWAIT_BAR(0);
        { bf16x8 kf[8], qr[4]; KLOAD(0); QLOAD(); __builtin_amdgcn_sched_barrier(0);
          pA0 = MFMA32(kf[0], qr[0], zero16); pA1 = MFMA32(kf[1], qr[0], zero16);
#pragma unroll
          for (int d0 = 1; d0 < 4; ++d0) { pA0 = MFMA32(kf[2 * d0], qr[d0], pA0); pA1 = MFMA32(kf[2 * d0 + 1], qr[d0], pA1); } }
        if (half == 1) ABAR();
#define SM_GRP(g, PC0, PC1, PN0, PN1, WITH_QK, SUBM) do { \
            if (WITH_QK) { if ((g) + 2 < 8) { kf[((g) + 2) & 7] = *(LAS const bf16x8*)(kb_ + (((g) + 2) >> 1) * 2048 + (((g) + 2) & 1) * 512); if ((((g) + 2) & 1) == 0) qr[(((g) + 2) >> 1) & 3] = *(LAS const bf16x8*)(qlds + (((g) + 2) >> 1) * 1024); } \
                           if ((g) == 0) PN0 = MFMA32(kf[0], qr[0], zero16); else if ((g) == 1) PN1 = MFMA32(kf[1], qr[0], zero16); else if (((g) & 1) == 0) PN0 = MFMA32(kf[g], qr[(g) >> 1], PN0); else PN1 = MFMA32(kf[g], qr[(g) >> 1], PN1); } \
            if (SUBM) { PC0[2 * (g)] -= mref; PC0[2 * (g) + 1] -= mref; PC1[2 * (g)] -= mref; PC1[2 * (g) + 1] -= mref; } \
            PC0[2 * (g)] = __builtin_amdgcn_exp2f(PC0[2 * (g)]); PC0[2 * (g) + 1] = __builtin_amdgcn_exp2f(PC0[2 * (g) + 1]); PC1[2 * (g)] = __builtin_amdgcn_exp2f(PC1[2 * (g)]); PC1[2 * (g) + 1] = __builtin_amdgcn_exp2f(PC1[2 * (g) + 1]); \
            ps2 += (f32x2){PC0[2 * (g)], PC0[2 * (g) + 1]}; ps2 += (f32x2){PC1[2 * (g)], PC1[2 * (g) + 1]}; \
            pw[(g) >> 2][(g) & 3] = cvt_pk_bf16(PC0[2 * (g)], PC0[2 * (g) + 1]); pw[2 + ((g) >> 2)][(g) & 3] = cvt_pk_bf16(PC1[2 * (g)], PC1[2 * (g) + 1]); \
            __builtin_amdgcn_sched_barrier(0); } while (0)
#define SM_ALL(PC0, PC1, PN0, PN1, WITH_QK, SUBM) do { SM_GRP(0, PC0, PC1, PN0, PN1, WITH_QK, SUBM); SM_GRP(1, PC0, PC1, PN0, PN1, WITH_QK, SUBM); SM_GRP(2, PC0, PC1, PN0, PN1, WITH_QK, SUBM); SM_GRP(3, PC0, PC1, PN0, PN1, WITH_QK, SUBM); \
            SM_GRP(4, PC0, PC1, PN0, PN1, WITH_QK, SUBM); SM_GRP(5, PC0, PC1, PN0, PN1, WITH_QK, SUBM); SM_GRP(6, PC0, PC1, PN0, PN1, WITH_QK, SUBM); SM_GRP(7, PC0, PC1, PN0, PN1, WITH_QK, SUBM); } while (0)
#define ATT_STEP(t, PC0, PC1, PN0, PN1) do { \
              \
            if (!(PMODE & 1) && half == 1) { if ((t) + 3 < NT) ADMA_K((t) + 3, s0); if ((t) + 2 < NT) ADMA_V((t) + 2, s2); } \
            bf16x8 kf[8], qr[4]; LAS const unsigned char* kb_ = shm + A_K + s1 * 8192 + hi * 1024 + r32 * 16; \
            kf[0] = *(LAS const bf16x8*)(kb_); kf[1] = *(LAS const bf16x8*)(kb_ + 512); qr[0] = *(LAS const bf16x8*)(qlds);     \
            asm volatile("s_nop 15\n\ts_nop 7" : "+v"(PC0), "+v"(PC1));        \
            float rm = max3f(PC0[0], PC0[1], PC1[0]), rm2 = max3f(PC0[2], PC0[3], PC1[1]); rm = max3f(rm, PC1[2], PC1[3]); \
            _Pragma("unroll") for (int r = 4; r < 16; r += 4) { rm = max3f(rm, PC0[r], PC0[r + 1]); rm2 = max3f(rm2, PC0[r + 2], PC0[r + 3]); rm = max3f(rm, PC1[r], PC1[r + 1]); rm2 = max3f(rm2, PC1[r + 2], PC1[r + 3]); } \
            rm = max3f(rm, rm2, rm2); \
            { auto rr = __builtin_amdgcn_permlane32_swap(__float_as_uint(rm), __float_as_uint(rm), false, false); rm = fmaxf(__uint_as_float(rr[0]), __uint_as_float(rr[1])); } \
            { bool need_ = rm > mref + 16.f; if ((t) == 0) need_ = need_ || (rm < -16.f);     \
              if (__any(need_)) { \
                const float mnew = (t) == 0 ? (need_ ? rm : 0.f) : fmaxf(rm, mref), alpha = (t) == 0 ? 0.f : __builtin_amdgcn_exp2f(mref - mnew); \
                lsum *= alpha; mref = mnew; anyref = 1; \
                if (hi == 0) wsf[r32] = alpha; \
                asm volatile("s_waitcnt lgkmcnt(0)" ::: "memory"); \
                _Pragma("unroll") for (int g4 = 0; g4 < 4; ++g4) { const f32x4 f = *(LAS const f32x4*)(wsf + 8 * g4 + 4 * hi); \
                    _Pragma("unroll") for (int d = 0; d < 4; ++d) { o[d][4 * g4] *= f[0]; o[d][4 * g4 + 1] *= f[1]; o[d][4 * g4 + 2] *= f[2]; o[d][4 * g4 + 3] *= f[3]; } } \
              } } \
            f32x2 ps2 = {0.f, 0.f}; u32x4 pw[4]; \
            __builtin_amdgcn_sched_barrier(0); \
            if (__builtin_amdgcn_readfirstlane(anyref)) SM_ALL(PC0, PC1, PN0, PN1, true, true); else SM_ALL(PC0, PC1, PN0, PN1, true, false);     \
            const float ps = ps2[0] + ps2[1]; \
            lsum += ps; \
            bf16x8 pa[4]; pa[0] = __builtin_bit_cast(bf16x8, pw[0]); pa[1] = __builtin_bit_cast(bf16x8, pw[1]); pa[2] = __builtin_bit_cast(bf16x8, pw[2]); pa[3] = __builtin_bit_cast(bf16x8, pw[3]); \
            if (!(PMODE & 8)) { if (half == 0) ABAR(); else { if ((t) + 3 < NT) AWAIT_BAR(3); else AWAIT_BAR(0); } } \
              \
            if (!(PMODE & 1) && half == 0) { if ((t) + 3 < NT) ADMA_K((t) + 3, s0); if ((t) + 2 < NT) ADMA_V((t) + 2, s2); } \
            { const int vb = vb0 + s0 * 16384; typedef short s16x4 __attribute__((ext_vector_type(4))); s16x4 vlo[4], vhh[4];     \
              VRD1(0); VRD1(1); VRD1(2); VRD1(3); \
              VSTEP(0, 6); VSTEP(1, 6); VSTEP(2, 6); VSTEP(3, 6); VSTEP(4, 6); VSTEP(5, 6); VSTEP(6, 6); VSTEP(7, 6); VSTEP(8, 6); VSTEP(9, 6); VSTEP(10, 6); VSTEP(11, 6); VSTEP(12, 6); \
              VSTEP(13, 4); VSTEP(14, 2); VSTEP(15, 0); } \
            if (!(PMODE & 8)) { if (half == 0) { if ((t) + 3 < NT) AWAIT_BAR(3); else AWAIT_BAR(0); } else ABAR(); } \
            { const int tmp = s0; s0 = s1; s1 = s2; s2 = tmp; } } while (0)
#define VRD1(i) do { asm volatile("ds_read_b64_tr_b16 %0,%1 offset:%c2" : "=&v"(vlo[(i) & 3]) : "v"(vb), "i"(((i) >> 2) * 4096 + ((i) & 3) * 1024) : "memory"); \
                     asm volatile("ds_read_b64_tr_b16 %0,%1 offset:%c2" : "=&v"(vhh[(i) & 3]) : "v"(vb), "i"(((i) >> 2) * 4096 + ((i) & 3) * 1024 + 512) : "memory"); } while (0)
#define VSTEP(i, N) do { asm volatile("s_waitcnt lgkmcnt(" #N ")" : "+v"(vlo[(i) & 3]), "+v"(vhh[(i) & 3]) :: "memory"); \
            { const bf16x8 vf = (bf16x8){vlo[(i) & 3][0], vlo[(i) & 3][1], vlo[(i) & 3][2], vlo[(i) & 3][3], vhh[(i) & 3][0], vhh[(i) & 3][1], vhh[(i) & 3][2], vhh[(i) & 3][3]}; o[(i) >> 2] = MFMA32(pa[(i) & 3], vf, o[(i) >> 2]); } \
            if ((i) + 4 < 16) VRD1((i) + 4); } while (0)
        int t = 0;
        for (; t + 1 < NT; t += 2) { ATT_STEP(t, pA0, pA1, pB0, pB1); ATT_STEP(t + 1, pB0, pB1, pA0, pA1); }
        if (t < NT) ATT_STEP(t, pA0, pA1, pB0, pB1);
#undef VRD1
#undef VSTEP
#undef ATT_STEP
#undef SM_GRP
#undef SM_ALL
        if (half == 0) ABAR();
        { auto rr = __builtin_amdgcn_permlane32_swap(__float_as_uint(lsum), __float_as_uint(lsum), false, false); lsum = __uint_as_float(rr[0]) + __uint_as_float(rr[1]); }
        if (hi == 0) wsf[r32] = lsum;
        asm volatile("s_waitcnt lgkmcnt(0)" ::: "memory");
        float rli[16];
#pragma unroll
        for (int g4 = 0; g4 < 4; ++g4) { const f32x4 f = *(LAS const f32x4*)(wsf + 8 * g4 + 4 * hi); rli[4 * g4] = __builtin_amdgcn_rcpf(f[0]); rli[4 * g4 + 1] = __builtin_amdgcn_rcpf(f[1]); rli[4 * g4 + 2] = __builtin_amdgcn_rcpf(f[2]); rli[4 * g4 + 3] = __builtin_amdgcn_rcpf(f[3]); }
        const __amdgpu_buffer_rsrc_t prs = __builtin_amdgcn_make_buffer_rsrc((void*)park, 0, 32768 * 4, 0x00020000);
        unsigned toff = (unsigned)tid * 4u; asm volatile("" : "+v"(toff));
        if (c == 0) {
#pragma unroll
            for (int d = 0; d < 4; ++d)
#pragma unroll
                for (int r = 0; r < 16; ++r) __builtin_amdgcn_raw_buffer_store_b32(__float_as_uint(o[d][r] * rli[r]), prs, toff, (d * 16 + r) * 2048, 0);
        } else {
            const __amdgpu_buffer_rsrc_t yrs = __builtin_amdgcn_make_buffer_rsrc((void*)Ya, 0, 64 * D * 2, 0x00020000);
            const __amdgpu_buffer_rsrc_t zrs = __builtin_amdgcn_make_buffer_rsrc((void*)Za, 0, 64 * D * 2, 0x00020000);
            unsigned yoff = (unsigned)(((32 * th + 4 * hi) * D + rep * 128 + r32) * 2); asm volatile("" : "+v"(yoff));
            float ss[16];
#pragma unroll
            for (int r = 0; r < 16; ++r) ss[r] = 0.f;
#pragma unroll
            for (int d = 0; d < 4; ++d) { float pv[16];
#pragma unroll
                for (int r = 0; r < 16; ++r) pv[r] = __uint_as_float(__builtin_amdgcn_raw_buffer_load_b32(prs, toff, (d * 16 + r) * 2048, 0));
#pragma unroll
                for (int r = 0; r < 16; ++r) { o[d][r] = pv[r] - lam * (o[d][r] * rli[r]); ss[r] += o[d][r] * o[d][r]; } }
            if (NTn > 0) {
                const unsigned kvn = (unsigned)(lane * 2048 + wid * 16);
                glds16s((const char*)Kbn, kvn, (unsigned)__builtin_amdgcn_readfirstlane(kdst)); glds16s((const char*)Vbn, vvoff, (unsigned)__builtin_amdgcn_readfirstlane(vdst0)); glds16s((const char*)Vbn + 128, vvoff, (unsigned)__builtin_amdgcn_readfirstlane(vdst1));
                if (NTn > 1) { glds16s((const char*)Kbn + 131072, kvn, (unsigned)__builtin_amdgcn_readfirstlane(kdst + 8192)); glds16s((const char*)Vbn + 131072, vvoff, (unsigned)__builtin_amdgcn_readfirstlane(vdst0 + 16384)); glds16s((const char*)Vbn + 131072 + 128, vvoff, (unsigned)__builtin_amdgcn_readfirstlane(vdst1 + 16384)); }
                if (NTn > 2) glds16s((const char*)Kbn + 2 * 131072, kvn, (unsigned)__builtin_amdgcn_readfirstlane(kdst + 2 * 8192));
#pragma unroll
                for (int d0 = 0; d0 < 4; ++d0) qx[d0] = *(const GAS bf16x8*)(Qbn + (size_t)(32 * th + r32) * D + rep * 128 + d0 * 16 + hi * 8);
            }
#pragma unroll
            for (int r = 0; r < 16; ++r) { float v = ss[r];
#define DPPA(x, ctrl) __builtin_bit_cast(float, __builtin_amdgcn_update_dpp(0, __builtin_bit_cast(int, (x)), (ctrl), 0xf, 0xf, true))
                v += DPPA(v, 0xB1); v += DPPA(v, 0x4E); v += DPPA(v, 0x141); v += DPPA(v, 0x140);
#undef DPPA
                v += __builtin_bit_cast(float, __builtin_amdgcn_ds_swizzle(__builtin_bit_cast(int, v), 0x401F));
                ss[r] = 0.8f * __builtin_amdgcn_rsqf(v * (1.f / 128.f) + EPS); }
#pragma unroll
            for (int d = 0; d < 4; ++d) { unsigned short zz[16]; const float wn = anw[32 * d + r32];
#pragma unroll
                for (int r = 0; r < 16; ++r) zz[r] = (unsigned short)__builtin_amdgcn_raw_buffer_load_b16(zrs, yoff, (((r & 3) + 8 * (r >> 2)) * D + 32 * d) * 2, 0);
#pragma unroll
                for (int r = 0; r < 16; ++r) { const float y = o[d][r] * ss[r] * wn * bf2f(zz[r]);
                    __builtin_amdgcn_raw_buffer_store_b16((short)f2bf(y), yrs, yoff, (((r & 3) + 8 * (r >> 2)) * D + 32 * d) * 2, 0); } }
        }
#undef ADMA_K
#undef ADMA_V
#undef KLOAD
#undef QKT
#undef QLOAD
    }
}

__device__ __forceinline__ void phase_norm(const Args& a, int tid, int bx, int G, bool dummy = false) {
    const int lane = tid & 63, wave = tid >> 6, gw = bx * 8 + wave, NGW = G * 8;
    bf16* YM = (bf16*)(a.ws + WS_YM); bf16* YA = (bf16*)(a.ws + WS_YA); const bf16* ZA = (const bf16*)(a.ws + WS_ZA);
    for (int it = gw; it < M * 8; it += NGW) {
        const int g = it & 7; bf16* p = YM + (size_t)(it >> 3) * DI + g * 1024 + lane * 8;
        const u32x4 v0 = *(const GAS u32x4*)p, v1 = *(const GAS u32x4*)(p + 512);
        float x[16] = {bf_lo(v0.x), bf_hi(v0.x), bf_lo(v0.y), bf_hi(v0.y), bf_lo(v0.z), bf_hi(v0.z), bf_lo(v0.w), bf_hi(v0.w), bf_lo(v1.x), bf_hi(v1.x), bf_lo(v1.y), bf_hi(v1.y), bf_lo(v1.z), bf_hi(v1.z), bf_lo(v1.w), bf_hi(v1.w)};
        float s = 0.f;
#pragma unroll
        for (int i = 0; i < 16; ++i) s += x[i] * x[i];
        const float rstd = 1.f / sqrtf(wave_sum(s) * (1.f / 1024.f) + EPS);
        const float* nw = a.in[I_MNW] + g * 1024 + lane * 8;
        const f32x4 w0 = *(const GAS f32x4*)nw, w1 = *(const GAS f32x4*)(nw + 4), w2 = *(const GAS f32x4*)(nw + 512), w3 = *(const GAS f32x4*)(nw + 516);
        u32x4 o0, o1;
        o0.x = cvt_pk_bf16(x[0] * rstd * w0[0], x[1] * rstd * w0[1]); o0.y = cvt_pk_bf16(x[2] * rstd * w0[2], x[3] * rstd * w0[3]); o0.z = cvt_pk_bf16(x[4] * rstd * w1[0], x[5] * rstd * w1[1]); o0.w = cvt_pk_bf16(x[6] * rstd * w1[2], x[7] * rstd * w1[3]);
        o1.x = cvt_pk_bf16(x[8] * rstd * w2[0], x[9] * rstd * w2[1]); o1.y = cvt_pk_bf16(x[10] * rstd * w2[2], x[11] * rstd * w2[3]); o1.z = cvt_pk_bf16(x[12] * rstd * w3[0], x[13] * rstd * w3[1]); o1.w = cvt_pk_bf16(x[14] * rstd * w3[2], x[15] * rstd * w3[3]);
        bf16* pw = dummy ? p + (WS_XBC - WS_YM) / 2 : p; *(GAS u32x4*)pw = o0; *(GAS u32x4*)(pw + 512) = o1;
    }
}
__device__ __forceinline__ void phase_final(const Args& a, int tid, int bx, int G, bool dummy = false) {
    const int lane = tid & 63, wave = __builtin_amdgcn_readfirstlane(tid >> 6), gw = bx * 8 + wave, NGW = G * 8;
    f32x4 wv[16];
#pragma unroll
    for (int j = 0; j < 16; ++j) wv[j] = *(const GAS f32x4*)(a.in[I_FNW] + 4 * (64 * j + lane));
    const bool split = USE_SPLIT && G == 256;
#define FIN_LOAD(dst, row) do { const bool sp_ = split && (row) >= MP; const float* xr_ = (row) < MP ? a.in[I_XP] + (size_t)(row) * D : a.in[I_XS] + (size_t)((row) - MP) * D; \
        const float* ps_ = (const float*)(a.ws + WS_PS) + (size_t)((row) - MP) * D; const bf16* dl_ = (const bf16*)(a.ws + WS_DLT) + (size_t)(row) * D; \
        _Pragma("unroll") for (int j = 0; j < 16; ++j) { const int e = 4 * (64 * j + lane); \
            if (sp_) dst[j] = *(const GAS f32x4*)(xr_ + e) + ((*(const GAS f32x4*)(ps_ + e) + *(const GAS f32x4*)(ps_ + (size_t)MS * D + e)) + (*(const GAS f32x4*)(ps_ + (size_t)2 * MS * D + e) + *(const GAS f32x4*)(ps_ + (size_t)3 * MS * D + e))); \
            else { const u32x2 d2 = *(const GAS u32x2*)(dl_ + e); dst[j] = *(const GAS f32x4*)(xr_ + e) + (f32x4){bf_lo(d2.x), bf_hi(d2.x), bf_lo(d2.y), bf_hi(d2.y)}; } } } while (0)
    f32x4 v[16], nv[16];
    if (gw < M) FIN_LOAD(nv, gw);
    for (int row = gw; row < M; row += NGW) {
#pragma unroll
        for (int j = 0; j < 16; ++j) v[j] = nv[j];
        if (row + NGW < M) FIN_LOAD(nv, row + NGW);
        float s = 0.f;
#pragma unroll
        for (int j = 0; j < 16; ++j) s += (v[j][0] * v[j][0] + v[j][1] * v[j][1]) + (v[j][2] * v[j][2] + v[j][3] * v[j][3]);
        const float rstd = 1.f / sqrtf(wave_sum(s) * (1.f / D) + EPS);
        float* yo = dummy ? (float*)(a.ws + WS_XBC) + (size_t)row * D : a.out + O_Y + (size_t)row * D;
#pragma unroll
        for (int j = 0; j < 16; ++j) *(GAS f32x4*)(yo + 4 * (64 * j + lane)) = v[j] * rstd * wv[j];
    }
#undef FIN_LOAD
}

__global__ void __launch_bounds__(512, 2) mega_fwd(Args args) {
    extern __shared__ __attribute__((aligned(16))) unsigned char lds_raw[];
    LAS unsigned char* lds = (LAS unsigned char*)lds_raw;
    volatile LAS unsigned* MISC = (volatile LAS unsigned*)(lds + MISC_OFF);
    const int tid = threadIdx.x, bx = blockIdx.x, G = gridDim.x;
    for (int u = tid; u < (LDS_BYTES - LDSCTL_OFF) / 4; u += 512) ((LAS unsigned*)(lds + LDSCTL_OFF))[u] = 0u;
    __syncthreads();
    unsigned* ctl = (unsigned*)(args.ws + WS_CTL);
    XcdBarrier bar; bar.bar = ctl + CW_BAR; bar.x = 0; bar.st = nullptr;
    if (MK_N_LAUNCHES == 1) bar = xcd_barrier_post(ctl + CW_BAR, MISC + 8);
    const int lo = args.ph_lo, hi = args.ph_hi;
#ifdef ONLY_PHASE
#define IN(k) ((k) == ONLY_PHASE && lo <= (k) && (k) < hi)
#else
#define IN(k) (lo <= (k) && (k) < hi)
#endif
#define SEAM(k) do { if (IN(k) && IN((k) + 1)) xcd_barrier(bar); } while (0)

#define REPLOOP(N) for (int rep_ = 0; rep_ < (N); ++rep_, ((rep_ < (N)) ? xcd_barrier(bar) : (void)0))
    if (IN(0)) { REPLOOP(REP_P0) phase_prologue(args, lds, tid, bx, G, rep_ == 0); } SEAM(0);
#ifndef REP_P1
#define REP_P1 1
#endif
    if (IN(1)) { REPLOOP(REP_P1) phase_h(args, tid, bx, G, rep_ ? WS_ZM : WS_H); } SEAM(1);
    if (IN(2)) REPLOOP(REP_P2) {
        pg8::Gemm g{(const bf16*)(args.ws + WS_H), (const bf16*)(args.ws + WS_WIN), M, NIN, D}; pg8::StaticOrder S; S.init(M, NIN, G, bx);
        EpiIn E{args.ws, args.out, args.in[I_DTB]};
        pg8::gemm_phase<EpiIn, pg8::StaticOrder, true, true>(lds, g, S, E);
    } SEAM(2);
    if (IN(3)) { REPLOOP(REP_P3) phase_conv(args, tid, bx, G); } SEAM(3);
    if (IN(4)) {
        const int vcu = (G % 8 == 0) ? (bx % 8) * (G / 8) + bx / 8 : bx;
#ifndef NO_SSD
#ifndef SSD_HI
#define SSD_HI 16
#endif
        const bool ssd_bal = (G == 256); const int s_nc = vcu >= 128 ? SSD_HI : 16 - SSD_HI, s_b0 = vcu >= 128 ? 0 : SSD_HI;
        const int ssd_n = ssd_bal ? (s_nc > 0 ? 2 : 1) : (vcu < 2304 ? (2304 - vcu + G - 1) / G : 0);
        REPLOOP(REP_SSD) for (int ui = 0; ui < ssd_n; ++ui) { const int u = ssd_bal ? (ui == 0 ? vcu : 256 + s_b0 * 128 + (vcu & 127)) : vcu + G * ui; const int snc = ssd_bal ? s_nc : 1;
#ifdef PROBE_SSD_MODE
            if (rep_ > 0) { float* dummy = (float*)(args.ws + WS_XBC) + (size_t)u * 8192;
                if (u < 256) { const int b = u >> 7, hd = u & 127; ssd_unit<PROBE_SSD_MODE>(args, lds, tid, b * 128, 128, b * 8192, hd, nullptr, dummy, false); }
                else { const int us = u - 256, b = us >> 7, hd = us & 127; ssd_unit<PROBE_SSD_MODE>(args, lds, tid, 256 + b, 1, MP + b * 64, hd, args.in[I_SSSM] + (size_t)us * 8192, dummy, false); }
                continue; }
#endif
            if (u < 256) { const int b = u >> 7, hd = u & 127; ssd_unit<0>(args, lds, tid, b * 128, 128, b * 8192, hd, nullptr, args.out + O_SP + (size_t)u * 8192, false); }
            else { const int us = u - 256, b = us >> 7, hd = us & 127; ssd_unit<0>(args, lds, tid, 256 + b, snc, MP + b * 64, hd, args.in[I_SSSM] + (size_t)us * 8192, args.out + O_SS + (size_t)us * 8192, true); }
        }
#endif
        __syncthreads();
#ifndef NO_ATTN
        float lam;
        { float s1 = 0.f, s2 = 0.f; const int l = tid & 63; s1 = args.in[I_LQ1][l] * args.in[I_LK1][l]; s2 = args.in[I_LQ2][l] * args.in[I_LK2][l]; s1 = wave_sum(s1); s2 = wave_sum(s2); lam = expf(s1) - expf(s2) + 0.2f; lam = __builtin_bit_cast(float, __builtin_amdgcn_readfirstlane(__builtin_bit_cast(int, lam))); }
        int tid_a = threadIdx.x; asm volatile("" : "+v"(tid_a));
        const bf16* Qg = (const bf16*)(args.ws + WS_Q); bf16* Yag = (bf16*)(args.ws + WS_YA); float* park = (float*)(args.ws + WS_PARK) + (size_t)bx * 32768;
#define ATT_UP(it_, sub_, KB, VB, NT_, QR0, HKV) do { if ((it_) < 1024) { const int bh_ = (it_) >> 6, pr_ = (it_) & 63, b_ = bh_ >> 3, chunk_ = (sub_) ? 127 - pr_ : pr_; HKV = bh_ & 7; NT_ = chunk_ + 1; QR0 = b_ * 8192 + chunk_ * 64; \
            KB = (const bf16*)(args.ws + WS_KB) + (size_t)b_ * 8192 * 1024 + HKV * 128; VB = (const bf16*)(args.ws + WS_VB) + (size_t)b_ * 8192 * 1024 + HKV * 128; } \
        else { const int su_ = (it_) - 1024, b_ = su_ >> 3; HKV = su_ & 7; NT_ = 33; QR0 = MP + b_ * 64; KB = (const bf16*)(args.ws + WS_KS) + (size_t)b_ * 2112 * 1024 + HKV * 128; VB = (const bf16*)(args.ws + WS_VS) + (size_t)b_ * 2112 * 1024 + HKV * 128; } } while (0)
        REPLOOP(REP_ATT) { bf16x8 qx[4];
#pragma unroll
          for (int d0 = 0; d0 < 4; ++d0) qx[d0] = (bf16x8){0, 0, 0, 0, 0, 0, 0, 0};
          bool pre = false; int it = vcu, sub = 0;
          while (it < 1152) {
            const bf16 *Kb, *Vb, *Kbn = nullptr, *Vbn = nullptr; int NT, qrow0, hkv, NTn = 0, qrow0n = 0, hkvn = 0;
            ATT_UP(it, sub, Kb, Vb, NT, qrow0, hkv);
            int itn = it, subn = sub + 1; if (subn >= (it < 1024 ? 2 : 1)) { subn = 0; itn = it + G; }
            const bool hasn = itn < 1152;
            if (hasn) ATT_UP(itn, subn, Kbn, Vbn, NTn, qrow0n, hkvn);
            attn_unit<0>(Kb, Vb, NT, Qg + (size_t)qrow0 * D + hkv * 512, Yag + (size_t)qrow0 * D + hkv * 512, (const bf16*)(args.ws + WS_ZA) + (size_t)qrow0 * D + hkv * 512, args.in[I_ANW], park, lam, lds, tid_a,
                         Kbn, Vbn, hasn ? NTn : 0, Qg + (size_t)qrow0n * D + hkvn * 512, pre, qx);
            pre = hasn; it = itn; sub = subn;
          }
        }
#undef ATT_UP
#endif
        asm volatile("s_waitcnt vmcnt(0) lgkmcnt(0)" ::: "memory"); __syncthreads();
    } SEAM(4);
#ifndef REP_P5
#define REP_P5 1
#endif
    if (IN(5)) { REPLOOP(REP_P5) phase_norm(args, tid, bx, G, rep_ > 0); } SEAM(5);
    if (IN(6)) {
        pg8::Gemm2 g{(const bf16*)(args.ws + WS_YM), (const bf16*)(args.ws + WS_WPM), DI, (const bf16*)(args.ws + WS_YA), (const bf16*)(args.ws + WS_WPA), D}; pg8::SplitOrder S; S.init(G, bx);
        EpiG12 E{(const bf16*)(args.ws + WS_GM), (const bf16*)(args.ws + WS_GA), (bf16*)(args.ws + WS_MERGED), (float*)(args.ws + WS_TS)};
        pg8::gemm_phase2<EpiG12, pg8::SplitOrder>(lds, g, S, E);
    } SEAM(6);
    if (IN(7)) {
        if (USE_SPLIT && G == 256) { const float* TS = (const float*)(args.ws + WS_TS); bf16* MG = (bf16*)(args.ws + WS_MERGED) + (size_t)MP * D;
            for (int i = bx * 512 + tid; i < MS * D / 8; i += G * 512) { f32x4 t0 = {0.f, 0.f, 0.f, 0.f}, t1 = {0.f, 0.f, 0.f, 0.f};
#pragma unroll
                for (int sl = 0; sl < 4; ++sl) { t0 += *(const GAS f32x4*)(TS + (size_t)sl * MS * D + (size_t)i * 8); t1 += *(const GAS f32x4*)(TS + (size_t)sl * MS * D + (size_t)i * 8 + 4); }
                *(GAS u32x4*)(MG + (size_t)i * 8) = pack8(t0, t1); } }
    } SEAM(7);
    if (IN(8)) REPLOOP(REP_P7) {
        pg8::Gemm g{(const bf16*)(args.ws + WS_MERGED), (const bf16*)(args.ws + WS_WOUT), M, D, D}; pg8::SplitOrder S; S.init(G, bx);
        EpiOut E{(const float*)(args.ws + WS_MOD), (bf16*)(args.ws + WS_DLT), (float*)(args.ws + WS_PS)};
        pg8::gemm_phase<EpiOut, pg8::SplitOrder, true, true>(lds, g, S, E);
    } SEAM(8);
#ifndef REP_P9
#define REP_P9 1
#endif
    if (IN(9)) { for (int rep_ = REP_P9 - 1; rep_ >= 0; --rep_) { phase_final(args, tid, bx, G, rep_ > 0); if (rep_) xcd_barrier(bar); } }
#undef IN
#undef SEAM
}

extern "C" void kernel_launch(void* const* d_in, const int* in_sizes, int n_in, void* d_out, int out_size, void* d_ws, size_t ws_size, hipStream_t stream) {
    static int grid = 0;
    if (grid == 0) {
        if (n_in != 27 || out_size != 126382080 || ws_size < WS_END) { fprintf(stderr, "kernel_launch: unexpected problem: n_in %d out %d ws %zu (need %zu); nothing launched\n", n_in, out_size, ws_size, (size_t)WS_END); grid = -1; return; }
        int dev = 0, cus = 0, per_cu = 0;
        if (hipGetDevice(&dev) != hipSuccess || hipDeviceGetAttribute(&cus, hipDeviceAttributeMultiprocessorCount, dev) != hipSuccess) { grid = -1; return; }
        if (hipFuncSetAttribute((const void*)mega_fwd, hipFuncAttributeMaxDynamicSharedMemorySize, LDS_BYTES) != hipSuccess) { fprintf(stderr, "kernel_launch: hipFuncSetAttribute failed\n"); grid = -1; return; }
        if (hipOccupancyMaxActiveBlocksPerMultiprocessor(&per_cu, (const void*)mega_fwd, 512, LDS_BYTES) != hipSuccess || per_cu < 1) fprintf(stderr, "kernel_launch: occupancy query says %d\n", per_cu);
        (void)hipGetLastError();
        grid = cus;
    }
    if (grid < 0) return;
    if (hipMemsetAsync((char*)d_ws + WS_CTL, 0, CTL_ZERO_BYTES, stream) != hipSuccess) return;
    Args a{};
    for (int i = 0; i < 27; ++i) a.in[i] = (const float*)d_in[i];
    a.out = (float*)d_out; a.ws = (unsigned char*)d_ws;
    if (MK_N_LAUNCHES == 1) { a.ph_lo = 0; a.ph_hi = N_PHASES; hipLaunchKernelGGL(mega_fwd, dim3(grid), dim3(512), LDS_BYTES, stream, a); }
    else { for (int p = 0; p < N_PHASES; ++p) { a.ph_lo = p; a.ph_hi = p + 1; hipLaunchKernelGGL(mega_fwd, dim3(grid), dim3(512), LDS_BYTES, stream, a); } }
    const hipError_t le = hipPeekAtLastError();
    if (le != hipSuccess) fprintf(stderr, "kernel_launch: launch failed: %s\n", hipGetErrorName(le));
}
```
